# Optimizing an MI355X kernel written in HIP

```python
import jax, jax.numpy as jnp
from jax import lax
import numpy as np

D_MODEL = 2048
BATCH = 2
SEQ = 16384
DEPTH = 2

HEAD_DIM = 128
A_GROUPS = ((128, 1), (512, 4), (2048, 16))
A_HEADS_PER_GROUP = 4
A_HEADS = A_HEADS_PER_GROUP * len(A_GROUPS)
A_WIDTH = A_HEADS * HEAD_DIM
A_OUT = A_HEADS_PER_GROUP * HEAD_DIM
B_HEADS = 8
B_WIDTH = B_HEADS * HEAD_DIM
IDX_HEADS = 16
IDX_DIM = 64
IDX_TOPK = 256
BLOCK = 128
MLP_HIDDEN = 4 * D_MODEL
ROPE_THETA = 10000.0
EPS = 1e-6
N_MOD = 6
N_IN = 3 * A_WIDTH + 3 * B_WIDTH + IDX_HEADS * IDX_DIM + IDX_DIM + IDX_HEADS

kernel_name = "hybrid_dilated_dsa_adaln_block"


def rms_norm(x, gain=None):
    xf = x.astype(jnp.float32)
    y = xf * lax.rsqrt(jnp.mean(xf * xf, axis=-1, keepdims=True) + EPS)
    if gain is not None:
        y = y * gain.astype(jnp.float32)
    return y.astype(x.dtype)


def rope(x, positions):
    d = x.shape[-1]
    half = d // 2
    inv_freq = jnp.power(ROPE_THETA, -jnp.arange(half, dtype=jnp.float32) * 2.0 / d)
    ang = positions.astype(jnp.float32)[..., None] * inv_freq
    cos = jnp.cos(ang)[:, :, None, :]
    sin = jnp.sin(ang)[:, :, None, :]
    xf = x.astype(jnp.float32)
    x1, x2 = xf[..., :half], xf[..., half:]
    return jnp.concatenate([x1 * cos - x2 * sin, x2 * cos + x1 * sin], axis=-1).astype(x.dtype)


def dilated_attention(q, k, v, window, dilation):
    b, s, h, d = q.shape
    r = dilation
    span = window // dilation
    blk = BLOCK
    chunk = r * blk
    sp = -(-s // chunk) * chunk
    m = sp // r
    nb = m // blk

    def to_blocks(t):
        t = jnp.pad(t, ((0, 0), (0, sp - s), (0, 0), (0, 0)))
        t = t.reshape(b, m, r, h, d).transpose(0, 2, 1, 3, 4)
        return t.reshape(b, r, nb, blk, h, d)

    def with_prev(t):
        prev = jnp.pad(t, ((0, 0), (0, 0), (1, 0), (0, 0), (0, 0), (0, 0)))[:, :, :-1]
        return jnp.concatenate([prev, t], axis=3)

    qb = to_blocks(q)
    kk = with_prev(to_blocks(k))
    vv = with_prev(to_blocks(v))
    scores = jnp.einsum('bpnqhd,bpnkhd->bpnhqk', qb, kk).astype(jnp.float32) * (d ** -0.5)
    qi = jnp.arange(blk)[:, None] + blk
    ki = jnp.arange(2 * blk)[None, :]
    dist = qi - ki
    key_idx = jnp.arange(nb)[:, None, None] * blk + ki - blk
    valid = (dist >= 0) & (dist <= span) & (key_idx >= 0)
    scores = jnp.where(valid[:, None], scores, -jnp.inf)
    mx = jnp.max(scores, axis=-1, keepdims=True)
    e = jnp.exp(scores - mx)
    den = jnp.sum(e, axis=-1)
    lse = jnp.swapaxes(mx[..., 0] + jnp.log(den), -1, -2)
    out = jnp.einsum('bpnhqk,bpnkhd->bpnqhd', e.astype(vv.dtype), vv).astype(jnp.float32)
    out = out / jnp.swapaxes(den, -1, -2)[..., None]

    def from_blocks(t):
        t = t.reshape((b, r, m) + t.shape[4:])
        t = jnp.swapaxes(t, 1, 2)
        return t.reshape((b, sp) + t.shape[3:])[:, :s]

    return from_blocks(out), from_blocks(lse)


def dsa_attention(q, k, v, q_idx, k_idx, w_idx):
    b, s, h, d = q.shape
    topk = min(IDX_TOPK, s // 4)
    nb = s // BLOCK
    key_pos = jnp.arange(s)
    gather = jax.vmap(lambda t, i: t[i])

    def one_block(i):
        start = i * BLOCK
        qi = lax.dynamic_slice_in_dim(q_idx, start, BLOCK, axis=1)
        wi = lax.dynamic_slice_in_dim(w_idx, start, BLOCK, axis=1)
        qb = lax.dynamic_slice_in_dim(q, start, BLOCK, axis=1)
        qpos = start + jnp.arange(BLOCK)
        logits = jnp.einsum('bqhd,bsd->bqhs', qi, k_idx).astype(jnp.float32) * (IDX_DIM ** -0.5)
        score = jnp.einsum('bqh,bqhs->bqs', wi.astype(jnp.float32), jax.nn.relu(logits))
        causal = key_pos[None, :] <= qpos[:, None]
        score = jnp.where(causal[None], score, -jnp.inf)
        _, sel = lax.top_k(score, topk)
        ks = gather(k, sel)
        vs = gather(v, sel)
        att = jnp.einsum('bqhd,bqkhd->bhqk', qb, ks).astype(jnp.float32) * (d ** -0.5)
        ok = sel <= qpos[None, :, None]
        att = jnp.where(ok[:, None], att, -jnp.inf)
        p = jax.nn.softmax(att, axis=-1)
        return jnp.einsum('bhqk,bqkhd->bqhd', p.astype(vs.dtype), vs)

    out = lax.map(one_block, jnp.arange(nb))
    return jnp.moveaxis(out, 0, 1).reshape(b, s, h, d)


def token_mixer(h, positions, w_in, a_q_gain, a_k_gain, b_q_gain, b_k_gain, idx_k_gain,
                w_gate, b_gate, w_proj_a, w_proj_b, w_out):
    b, s, _ = h.shape
    z = h @ w_in
    sizes = (A_WIDTH, A_WIDTH, A_WIDTH, B_WIDTH, B_WIDTH, B_WIDTH,
             IDX_HEADS * IDX_DIM, IDX_DIM, IDX_HEADS)
    cuts = []
    acc = 0
    for sz in sizes[:-1]:
        acc += sz
        cuts.append(acc)
    aq, ak, av, bq, bk, bv, iq, ik, iw = jnp.split(z, cuts, axis=-1)

    aq = rope(rms_norm(aq.reshape(b, s, A_HEADS, HEAD_DIM), a_q_gain), positions)
    ak = rope(rms_norm(ak.reshape(b, s, A_HEADS, HEAD_DIM), a_k_gain), positions)
    av = av.reshape(b, s, A_HEADS, HEAD_DIM)
    outs, lses = [], []
    for g, (win, dil) in enumerate(A_GROUPS):
        sl = slice(g * A_HEADS_PER_GROUP, (g + 1) * A_HEADS_PER_GROUP)
        o, lse = dilated_attention(aq[:, :, sl], ak[:, :, sl], av[:, :, sl], win, dil)
        outs.append(o)
        lses.append(lse)
    wts = jax.nn.softmax(jnp.stack(lses), axis=0)
    o_a = jnp.sum(wts[..., None] * jnp.stack(outs), axis=0).astype(h.dtype).reshape(b, s, A_OUT)

    bq = rope(rms_norm(bq.reshape(b, s, B_HEADS, HEAD_DIM), b_q_gain), positions)
    bk = rope(rms_norm(bk.reshape(b, s, B_HEADS, HEAD_DIM), b_k_gain), positions)
    bv = bv.reshape(b, s, B_HEADS, HEAD_DIM)
    iq = rope(iq.reshape(b, s, IDX_HEADS, IDX_DIM), positions)
    ik = rope(rms_norm(ik, idx_k_gain)[:, :, None, :], positions)[:, :, 0, :]
    iw = iw * (IDX_HEADS ** -0.5)
    o_b = dsa_attention(bq, bk, bv, iq, ik, iw).reshape(b, s, B_WIDTH)

    gates = jax.nn.sigmoid((h @ w_gate + b_gate).astype(jnp.float32)).astype(h.dtype)
    g_a, g_b = jnp.split(gates, 2, axis=-1)
    merged = g_a * (o_a @ w_proj_a) + g_b * (o_b @ w_proj_b)
    return merged @ w_out


def setup_inputs(seed: int = 0) -> dict:
    key = jax.random.key(seed)
    ks = jax.random.split(key, 20)
    f32 = jnp.float32

    def nrm(k, shape, scale):
        return jax.random.normal(k, shape, f32) * scale

    def gain(k, n):
        return 1.0 + 0.02 * jax.random.normal(k, (DEPTH, n), f32)

    x = jax.random.normal(ks[0], (BATCH, SEQ, D_MODEL), f32)
    c = jax.random.normal(ks[1], (BATCH, D_MODEL), f32)
    offset = jax.random.randint(ks[2], (BATCH, 1), 0, 1024, dtype=jnp.int32)
    positions = (jnp.arange(SEQ, dtype=jnp.int32)[None, :] + offset).astype(jnp.int32)
    return {
        "x": x,
        "c": c,
        "positions": positions,
        "w_ada": nrm(ks[3], (DEPTH, D_MODEL, N_MOD * D_MODEL), D_MODEL ** -0.5),
        "b_ada": nrm(ks[4], (DEPTH, N_MOD * D_MODEL), 0.01),
        "w_in": nrm(ks[5], (DEPTH, D_MODEL, N_IN), D_MODEL ** -0.5),
        "a_q_gain": gain(ks[6], HEAD_DIM),
        "a_k_gain": gain(ks[7], HEAD_DIM),
        "b_q_gain": gain(ks[8], HEAD_DIM),
        "b_k_gain": gain(ks[9], HEAD_DIM),
        "idx_k_gain": gain(ks[10], IDX_DIM),
        "w_gate": nrm(ks[11], (DEPTH, D_MODEL, 2 * D_MODEL), D_MODEL ** -0.5),
        "b_gate": nrm(ks[12], (DEPTH, 2 * D_MODEL), 0.01),
        "w_proj_a": nrm(ks[13], (DEPTH, A_OUT, D_MODEL), A_OUT ** -0.5),
        "w_proj_b": nrm(ks[14], (DEPTH, B_WIDTH, D_MODEL), B_WIDTH ** -0.5),
        "w_out": nrm(ks[15], (DEPTH, D_MODEL, D_MODEL), D_MODEL ** -0.5),
        "w_up": nrm(ks[16], (DEPTH, D_MODEL, MLP_HIDDEN), D_MODEL ** -0.5),
        "w_down": nrm(ks[17], (DEPTH, MLP_HIDDEN, D_MODEL), MLP_HIDDEN ** -0.5),
    }


def reference(x, c, positions, w_ada, b_ada, w_in, a_q_gain, a_k_gain, b_q_gain, b_k_gain,
              idx_k_gain, w_gate, b_gate, w_proj_a, w_proj_b, w_out, w_up, w_down):
    c_act = jax.nn.silu(c)
    for l in range(DEPTH):
        mod = c_act @ w_ada[l] + b_ada[l]
        sh1, sc1, g1, sh2, sc2, g2 = jnp.split(mod, N_MOD, axis=-1)
        h = rms_norm(x) * (1.0 + sc1[:, None]) + sh1[:, None]
        mix = token_mixer(h, positions, w_in[l], a_q_gain[l], a_k_gain[l], b_q_gain[l],
                          b_k_gain[l], idx_k_gain[l], w_gate[l], b_gate[l],
                          w_proj_a[l], w_proj_b[l], w_out[l])
        x = x + g1[:, None] * mix
        h = rms_norm(x) * (1.0 + sc2[:, None]) + sh2[:, None]
        ffn = jnp.square(jax.nn.relu(h @ w_up[l])) @ w_down[l]
        x = x + g2[:, None] * ffn
    return x
```

```cpp
#include <hip/hip_runtime.h>
#include <hip/hip_cooperative_groups.h>
#include <cstdio>
#include <cstdint>
namespace cg = cooperative_groups;
namespace pg8 {
#define PG8_LAS __attribute__((address_space(3)))
typedef unsigned short bf16_t;
typedef short bf16x8 __attribute__((ext_vector_type(8)));
typedef float f32x4 __attribute__((ext_vector_type(4)));
typedef unsigned u32x4 __attribute__((ext_vector_type(4)));
constexpr int BM = 256, BK = 64, HALF = 128, HTB = HALF * BK * 2  , STAGE_BYTES = 8 * HTB, NXCD = 8, WGM = 4;

__host__ __device__ __forceinline__ int lds_byte(int r, int c) { const int st = (r >> 4) * 2 + (c >> 5), rr = r & 15, cc = c & 31, ob = rr * 64 + cc * 2; return st * 1024 + (ob ^ (((ob >> 9) & 1) << 5)); }
__host__ __device__ __forceinline__ void stage_rc(int b, int& R, int& C) { const int st = b / 1024, sb = b % 1024, swz = sb ^ (((sb >> 9) & 1) << 5); R = (st >> 1) * 16 + swz / 64; C = (st & 1) * 32 + (swz % 64) / 2; }
__host__ __device__ __forceinline__ int perm32(int rho) { const int n = rho >> 4, i = rho & 15; return 8 * (i >> 2) + 4 * n + (i & 3); }

struct Unit { int pm, pn; };
struct Gemm { const bf16_t* A; const bf16_t* Bt; int M, N, K; };

struct StaticOrder {
    int nM, nN, nwg, G, c;
    __host__ __device__ void init(int M, int N, int G_, int c_) { nM = M / BM; nN = N / BM; nwg = nM * nN; G = G_; c = c_; }
    __host__ __device__ bool next(int i, Unit& u) const {
        const long L = (long)i * G + c; if (L >= nwg) return false;
        int wgid = (int)L; { const int q = nwg / NXCD, r = nwg % NXCD, xcd = wgid % NXCD, off = wgid / NXCD; wgid = (xcd < r ? xcd * (q + 1) : r * (q + 1) + (xcd - r) * q) + off; }
        const int nig = WGM * nN, gid = wgid / nig, fm = gid * WGM, gsz = (nM - fm) < WGM ? (nM - fm) : WGM;
        u.pm = fm + ((wgid % nig) % gsz); u.pn = (wgid % nig) / gsz; return true;
    }
    __device__ __forceinline__ void a_ready(const Unit&) const {}
    __device__ __forceinline__ void done(const Unit&) const {}
};

__device__ __forceinline__ unsigned cvt_pk_bf16(float lo, float hi) { unsigned r; asm volatile("v_cvt_pk_bf16_f32 %0, %1, %2" : "=v"(r) : "v"(lo), "v"(hi)); return r; }
template <class Epi, class Sched, bool ALIGN_EPI = false, bool SP2 = false, bool F8 = false>
__device__ __forceinline__ void gemm_phase(PG8_LAS unsigned char* lds, const Gemm g, const Sched& S, const Epi& E) {
    int tid_ = threadIdx.x; asm volatile("" : "+v"(tid_)); const int tid = tid_, wid = __builtin_amdgcn_readfirstlane(tid >> 6), lane = tid & 63, wr = wid >> 2, wc = wid & 3, fr = lane & 15, fq = lane >> 4;
    const int K = g.K, nt = K / BK;
    unsigned voffA[2], voffB[2];
#pragma unroll
    for (int i = 0; i < 2; ++i) { int R, C; stage_rc(tid * 16 + i * 8192, R, C); const int Rb = Epi::PERM ? ((R & ~31) + perm32(R & 31)) : R;
        voffA[i] = (unsigned)(R * K + C) * 2u; voffB[i] = (unsigned)(Rb * K + C) * 2u; }
    const size_t kstep = (size_t)(BK * 2);
    const size_t hstep = (size_t)HALF * K * 2;
    const size_t tstep = 2 * hstep;
    const unsigned ldsw = (unsigned)wid * 1024u;
    const int aoff = lds_byte(wr * 64 + fr, fq * 8), boff = lds_byte(wc * 32 + fr, fq * 8);
#define PG8_SA(b, h) (((b) * 2 + (h)) * HTB)
#define PG8_SB(b, h) ((4 + (b) * 2 + (h)) * HTB)
#define PG8_STAGE(bufoff, gbase, voff) do { _Pragma("unroll") for (int _i = 0; _i < 2; ++_i) \
        __builtin_amdgcn_global_load_lds((const unsigned*)((const char*)(gbase) + (voff)[_i]), (PG8_LAS unsigned*)(lds + (bufoff) + ldsw + _i * 8192), 16, 0, 0); } while (0)
#define PG8_CAT8(p0, p1) __builtin_shufflevector(*(const PG8_LAS i4_t*)(p0), *(const PG8_LAS i4_t*)(p1), 0, 1, 2, 3, 4, 5, 6, 7)
#define PG8_LDA(dst, b, h) do { if constexpr (F8) { _Pragma("unroll") for (int m = 0; m < 4; ++m) dst##8[m] = PG8_CAT8(lds + PG8_SA(b, h) + aoff + m * 2048, lds + PG8_SA(b, h) + aoff + m * 2048 + 1024); } \
        else { _Pragma("unroll") for (int m = 0; m < 4; ++m) _Pragma("unroll") for (int k = 0; k < 2; ++k) dst[m][k] = *(const PG8_LAS bf16x8*)(lds + PG8_SA(b, h) + aoff + m * 2048 + k * 1024); } } while (0)
#define PG8_LDB(dst, b, h) do { if constexpr (F8) { _Pragma("unroll") for (int n = 0; n < 2; ++n) dst##8[n] = PG8_CAT8(lds + PG8_SB(b, h) + boff + n * 2048, lds + PG8_SB(b, h) + boff + n * 2048 + 1024); } \
        else { _Pragma("unroll") for (int n = 0; n < 2; ++n) _Pragma("unroll") for (int k = 0; k < 2; ++k) dst[n][k] = *(const PG8_LAS bf16x8*)(lds + PG8_SB(b, h) + boff + n * 2048 + k * 1024); } } while (0)
#define PG8_MMA(ai, bj, At, Bt) do { __builtin_amdgcn_s_setprio(1); \
        if constexpr (F8) { _Pragma("unroll") for (int m = 0; m < 4; ++m) _Pragma("unroll") for (int n = 0; n < 2; ++n) \
                asm volatile("v_mfma_scale_f32_16x16x128_f8f6f4 %0, %1, %2, %0, %3, %3 op_sel_hi:[0,0,0]" : "+v"(acc[ai][bj][m][n]) : "v"(Bt##8[n]), "v"(At##8[m]), "v"(f8scale)); } \
        else { _Pragma("unroll") for (int m = 0; m < 4; ++m) _Pragma("unroll") for (int n = 0; n < 2; ++n) _Pragma("unroll") for (int k = 0; k < 2; ++k) \
                acc[ai][bj][m][n] = __builtin_amdgcn_mfma_f32_16x16x32_bf16(Bt[n][k], At[m][k], acc[ai][bj][m][n], 0, 0, 0); } \
        __builtin_amdgcn_s_setprio(0); } while (0)
#define PG8_WAIT_V(n) asm volatile("s_waitcnt vmcnt(" #n ")" ::: "memory")
#define PG8_WAIT_L(n) asm volatile("s_waitcnt lgkmcnt(" #n ")" ::: "memory")
#define PG8_BAR __builtin_amdgcn_s_barrier()
#define PG8_SCHED __builtin_amdgcn_sched_barrier(0)
    Unit cur, nxt; int ui = 0;
    if (!S.next(0, cur)) return;
    f32x4 acc[2][2][4][2];
#pragma unroll
    for (int a = 0; a < 2; ++a)
#pragma unroll
        for (int b = 0; b < 2; ++b)
#pragma unroll
            for (int m = 0; m < 4; ++m)
#pragma unroll
                for (int n = 0; n < 2; ++n) acc[a][b][m][n] = (f32x4){0.f, 0.f, 0.f, 0.f};
    typedef int i8_t __attribute__((ext_vector_type(8))); typedef int i4_t __attribute__((ext_vector_type(4)));
    bf16x8 At[4][2], B0[2][2], B1[2][2]; i8_t At8[4], B08[2], B18[2];
    int f8scale = 0x7f7f7f7f; asm volatile("" : "+v"(f8scale));
    const char* cA = (const char*)g.A + (size_t)cur.pm * tstep; const char* cB = (const char*)g.Bt + (size_t)cur.pn * tstep;
    S.a_ready(cur);
    if constexpr (SP2) {
        PG8_STAGE(PG8_SB(0, 0), cB, voffB); PG8_STAGE(PG8_SB(0, 1), cB + hstep, voffB); PG8_STAGE(PG8_SA(0, 0), cA, voffA); PG8_STAGE(PG8_SA(0, 1), cA + hstep, voffA);
        if (wr == 1) PG8_BAR;
        PG8_WAIT_V(2); PG8_BAR;
        PG8_STAGE(PG8_SB(1, 0), cB + kstep, voffB); PG8_STAGE(PG8_SA(1, 0), cA + kstep, voffA); PG8_STAGE(PG8_SB(1, 1), cB + hstep + kstep, voffB);
        PG8_WAIT_V(6); PG8_BAR;
    } else {
        PG8_STAGE(PG8_SB(0, 0), cB, voffB); PG8_STAGE(PG8_SA(0, 0), cA, voffA); PG8_STAGE(PG8_SB(0, 1), cB + hstep, voffB); PG8_STAGE(PG8_SA(0, 1), cA + hstep, voffA);
        if (wr == 1) PG8_BAR;
        PG8_WAIT_V(4); PG8_BAR;
        PG8_STAGE(PG8_SB(1, 0), cB + kstep, voffB); PG8_STAGE(PG8_SA(1, 0), cA + kstep, voffA); PG8_STAGE(PG8_SB(1, 1), cB + hstep + kstep, voffB);
        PG8_WAIT_V(6); PG8_BAR;
    }
    for (;;) {
        const bool has_next = S.next(ui + 1, nxt);
        const char* nA = has_next ? (const char*)g.A + (size_t)nxt.pm * tstep : cA; const char* nB = has_next ? (const char*)g.Bt + (size_t)nxt.pn * tstep : cB;
        for (int t = 0; t < nt; t += 2) {
            const bool last = (t == nt - 2);
            const char* a1 = cA + (size_t)(t + 1) * kstep;
            const char* a2 = last ? nA : cA + (size_t)(t + 2) * kstep; const char* b2 = last ? nB : cB + (size_t)(t + 2) * kstep;
            const char* a3 = a2 + kstep; const char* b3 = b2 + kstep;
            if (last && has_next) S.a_ready(nxt);
            if constexpr (SP2) {
            PG8_LDB(B0, 0, 0); PG8_LDB(B1, 0, 1); PG8_SCHED; PG8_LDA(At, 0, 0); PG8_STAGE(PG8_SA(1, 1), a1 + hstep, voffA);
            PG8_WAIT_V(8); PG8_WAIT_L(0); PG8_BAR; PG8_MMA(0, 0, At, B0); PG8_MMA(0, 1, At, B1); PG8_BAR; PG8_SCHED;
            PG8_LDA(At, 0, 1); PG8_STAGE(PG8_SB(0, 0), b2, voffB); PG8_STAGE(PG8_SB(0, 1), b2 + hstep, voffB); PG8_STAGE(PG8_SA(0, 0), a2, voffA);
            PG8_WAIT_V(8); PG8_WAIT_L(0); PG8_BAR; PG8_MMA(1, 0, At, B0); PG8_MMA(1, 1, At, B1); PG8_BAR; PG8_SCHED;
            PG8_LDB(B0, 1, 0); PG8_LDB(B1, 1, 1); PG8_SCHED; PG8_LDA(At, 1, 0); PG8_STAGE(PG8_SA(0, 1), a2 + hstep, voffA);
            PG8_WAIT_V(8); PG8_WAIT_L(0); PG8_BAR; PG8_MMA(0, 0, At, B0); PG8_MMA(0, 1, At, B1); PG8_BAR; PG8_SCHED;
            PG8_LDA(At, 1, 1); PG8_STAGE(PG8_SB(1, 0), b3, voffB); PG8_STAGE(PG8_SB(1, 1), b3 + hstep, voffB); PG8_STAGE(PG8_SA(1, 0), a3, voffA);
            PG8_WAIT_V(8); PG8_WAIT_L(0); PG8_BAR; PG8_MMA(1, 0, At, B0); PG8_MMA(1, 1, At, B1); PG8_BAR; PG8_SCHED;
            } else {
            PG8_LDB(B0, 0, 0); PG8_SCHED; PG8_LDA(At, 0, 0); PG8_STAGE(PG8_SA(1, 1), a1 + hstep, voffA);
            PG8_WAIT_L(8); PG8_BAR; PG8_WAIT_L(0); PG8_MMA(0, 0, At, B0); PG8_BAR; PG8_SCHED;
            PG8_LDB(B1, 0, 1); PG8_STAGE(PG8_SB(0, 0), b2, voffB);
            PG8_BAR; PG8_WAIT_L(0); PG8_MMA(0, 1, At, B1); PG8_BAR;
            PG8_LDA(At, 0, 1); PG8_STAGE(PG8_SA(0, 0), a2, voffA);
            PG8_BAR; PG8_WAIT_L(0); PG8_MMA(1, 0, At, B0); PG8_BAR; PG8_SCHED;
            PG8_STAGE(PG8_SB(0, 1), b2 + hstep, voffB);
            PG8_WAIT_V(6); PG8_BAR; PG8_MMA(1, 1, At, B1); PG8_BAR;
            PG8_LDB(B0, 1, 0); PG8_SCHED; PG8_LDA(At, 1, 0); PG8_STAGE(PG8_SA(0, 1), a2 + hstep, voffA);
            PG8_WAIT_L(8); PG8_BAR; PG8_WAIT_L(0); PG8_MMA(0, 0, At, B0); PG8_BAR; PG8_SCHED;
            PG8_LDB(B1, 1, 1); PG8_STAGE(PG8_SB(1, 0), b3, voffB);
            PG8_BAR; PG8_WAIT_L(0); PG8_MMA(0, 1, At, B1); PG8_BAR;
            PG8_LDA(At, 1, 1); PG8_STAGE(PG8_SA(1, 0), a3, voffA);
            PG8_BAR; PG8_WAIT_L(0); PG8_MMA(1, 0, At, B0); PG8_BAR; PG8_SCHED;
            PG8_STAGE(PG8_SB(1, 1), b3 + hstep, voffB);
            PG8_WAIT_V(6); PG8_BAR; PG8_MMA(1, 1, At, B1); PG8_BAR;
            }
        }
        if constexpr (ALIGN_EPI) { if (wr == 0) PG8_BAR; }
        if constexpr (F8) asm volatile("s_nop 15\n\ts_nop 15" : "+v"(acc[1][1][0][0]), "+v"(acc[1][1][0][1]), "+v"(acc[1][1][1][0]), "+v"(acc[1][1][1][1]), "+v"(acc[1][1][2][0]), "+v"(acc[1][1][2][1]), "+v"(acc[1][1][3][0]), "+v"(acc[1][1][3][1]));
        if constexpr (!Epi::AFTER_DRAIN) { E(acc, cur, wr, wc, fr, fq); S.done(cur); }
        if (!has_next) break;
#pragma unroll
        for (int a = 0; a < 2; ++a)
#pragma unroll
            for (int b = 0; b < 2; ++b)
#pragma unroll
                for (int m = 0; m < 4; ++m)
#pragma unroll
                    for (int n = 0; n < 2; ++n) acc[a][b][m][n] = (f32x4){0.f, 0.f, 0.f, 0.f};
        cur = nxt; cA = nA; cB = nB; ++ui;
        if constexpr (ALIGN_EPI) { if (wr == 1) PG8_BAR; }
    }
    PG8_WAIT_V(0);
    if constexpr (!ALIGN_EPI) { if (wr == 0) PG8_BAR; }
    PG8_BAR;
    if constexpr (Epi::AFTER_DRAIN) { E.fused(acc, cur, wr, wc, fr, fq, lds, wid, lane); S.done(cur); }
#undef PG8_SA
#undef PG8_SB
#undef PG8_STAGE
#undef PG8_LDA
#undef PG8_CAT8
#undef PG8_LDB
#undef PG8_MMA
#undef PG8_WAIT_V
#undef PG8_WAIT_L
#undef PG8_BAR
#undef PG8_SCHED
}
}

using pg8::bf16_t; using pg8::bf16x8; using pg8::f32x4; using pg8::u32x4;
typedef unsigned u32x2 __attribute__((ext_vector_type(2)));
#define LAS __attribute__((address_space(3)))
constexpr int DM = 2048, NB = 2, SEQ = 16384, DEPTH = 2;
constexpr int NIN = 8784, NINP = 8960, QKVW = 7680, IDXW = 1280, HIDN = 8192, NMOD = 12288;
constexpr int COL_AQ = 0, COL_AK = 1536, COL_AV = 3072, COL_BQ = 4608, COL_BK = 5632, COL_BV = 6656;
constexpr float EPS = 1e-6f;
constexpr int NWAVES = 8, NTHREADS = 512;
constexpr int LDS_BYTES = 147456;
constexpr size_t MiB = 1u << 20;
constexpr size_t WS_MOD = 0, WS_RS = 256 * 1024  , WS_BVEC = 320 * 1024  , WS_BAR = 512 * 1024, BAR_BYTES = 16384, WS_W = 1 * MiB;
constexpr size_t W_I16 = 0, W_IN8 = 5 * MiB, W_G8 = 20 * MiB, W_PA = 35 * MiB, W_PB = 37 * MiB, W_O = 41 * MiB, W_UP = 49 * MiB, W_DN = 81 * MiB, W_LAYER = 113 * MiB;
constexpr float W8_SCALE = 64.f;
constexpr size_t WS_H = WS_W + 2 * W_LAYER;
constexpr size_t WS_QKV = WS_H + 64 * MiB;
constexpr size_t WS_IDXF = WS_QKV + 240 * MiB;
constexpr size_t WS_HID = WS_QKV;
constexpr size_t WS_IQ = WS_IDXF + 80 * MiB;
constexpr size_t WS_IK = WS_IQ + 32 * MiB;
constexpr size_t WS_IW = WS_IK + 2 * MiB;
constexpr size_t WS_SEL = WS_IW + 1 * MiB;
constexpr size_t WS_OA = WS_SEL + 8 * MiB;
constexpr size_t WS_OB = WS_OA + 16 * MiB;
constexpr size_t WS_G = WS_OB + 32 * MiB;
constexpr size_t WS_MRG = WS_G + 128 * MiB;
constexpr size_t WS_OG = WS_MRG + 64 * MiB;
constexpr size_t WS_LSE = WS_OG + 48 * MiB;
constexpr size_t WS_K8 = WS_LSE + 1 * MiB;
constexpr size_t WS_V8 = WS_K8 + 16 * MiB;
constexpr size_t WS_H8 = WS_V8 + 16 * MiB;
constexpr size_t WS_END = WS_H8 + 32 * MiB;
static_assert(WS_END <= (size_t)1024 * MiB, "workspace map");
constexpr int N_PHASES = 1 + NB * DEPTH * 10;

__device__ const float INVF[64] = {1.0f,0.865964353f,0.749894261f,0.649381638f,0.562341332f,0.486967534f,0.421696514f,0.365174115f,0.316227764f,0.273841977f,0.237137377f,0.2053525f,0.177827939f,0.153992653f,0.133352131f,0.115478203f,0.100000001f,0.0865964293f,0.0749894157f,0.0649381652f,0.0562341325f,0.0486967526f,0.0421696529f,0.0365174115f,0.0316227749f,0.0273841973f,0.0237137377f,0.0205352511f,0.0177827943f,0.0153992651f,0.0133352149f,0.0115478206f,0.00999999978f,0.00865964312f,0.00749894185f,0.00649381615f,0.00562341325f,0.00486967526f,0.00421696482f,0.00365174119f,0.00316227763f,0.00273841969f,0.00237137359f,0.00205352483f,0.00177827943f,0.00153992651f,0.00133352145f,0.0011547819f,0.00100000005f,0.000865964335f,0.000749894243f,0.000649381662f,0.000562341302f,0.000486967532f,0.000421696517f,0.000365174143f,0.000316227757f,0.000273841957f,0.00023713737f,0.00020535251f,0.00017782794f,0.000153992645f,0.00013335215f,0.0001154782f};

__device__ __forceinline__ float bf2f(unsigned u16) { return __builtin_bit_cast(float, u16 << 16); }
__device__ __forceinline__ unsigned f2bf(float f) { unsigned u = __builtin_bit_cast(unsigned, f); return (u + 0x7fffu + ((u >> 16) & 1u)) >> 16; }
__device__ __forceinline__ unsigned pk2(float lo, float hi) { return f2bf(lo) | (f2bf(hi) << 16); }
template <int CTRL> __device__ __forceinline__ float dpp_f(float v) { return __builtin_bit_cast(float, __builtin_amdgcn_update_dpp(0, __builtin_bit_cast(int, v), CTRL, 0xF, 0xF, true)); }
template <int CTRL> __device__ __forceinline__ int dpp_i(int v) { return __builtin_amdgcn_update_dpp(0, v, CTRL, 0xF, 0xF, true); }
__device__ __forceinline__ void pl32(unsigned a, unsigned b, unsigned& ra, unsigned& rb) { asm volatile("" : "+v"(b)); auto r = __builtin_amdgcn_permlane32_swap(a, b, false, false); ra = r[0]; rb = r[1]; asm volatile("" : "+v"(ra), "+v"(rb)); }
__device__ __forceinline__ void pl16(unsigned a, unsigned b, unsigned& ra, unsigned& rb) { asm volatile("" : "+v"(b)); auto r = __builtin_amdgcn_permlane16_swap(a, b, false, false); ra = r[0]; rb = r[1]; asm volatile("" : "+v"(ra), "+v"(rb)); }
__device__ __forceinline__ float swap32_sum(float a, float b) { unsigned x, y; pl32(__builtin_bit_cast(unsigned, a), __builtin_bit_cast(unsigned, b), x, y); return __builtin_bit_cast(float, x) + __builtin_bit_cast(float, y); }
__device__ __forceinline__ float swap16_sum(float a, float b) { unsigned x, y; pl16(__builtin_bit_cast(unsigned, a), __builtin_bit_cast(unsigned, b), x, y); return __builtin_bit_cast(float, x) + __builtin_bit_cast(float, y); }
__device__ __forceinline__ float wave_sum(float v) {
    v += dpp_f<0x128>(v); v += dpp_f<0x124>(v); v += dpp_f<0x4E>(v); v += dpp_f<0xB1>(v);
    v = swap16_sum(v, v); return swap32_sum(v, v);
}
__device__ __forceinline__ float wave_max(float v) {
    v = fmaxf(v, dpp_f<0x128>(v)); v = fmaxf(v, dpp_f<0x124>(v)); v = fmaxf(v, dpp_f<0x4E>(v)); v = fmaxf(v, dpp_f<0xB1>(v));
    unsigned x, y;
    pl16(__builtin_bit_cast(unsigned, v), __builtin_bit_cast(unsigned, v), x, y); v = fmaxf(__builtin_bit_cast(float, x), __builtin_bit_cast(float, y));
    pl32(__builtin_bit_cast(unsigned, v), __builtin_bit_cast(unsigned, v), x, y); v = fmaxf(__builtin_bit_cast(float, x), __builtin_bit_cast(float, y));
    return v;
}
__device__ __forceinline__ int wave_sum_i(int v) {
    v += dpp_i<0x128>(v); v += dpp_i<0x124>(v); v += dpp_i<0x4E>(v); v += dpp_i<0xB1>(v);
    unsigned x, y;
    pl16((unsigned)v, (unsigned)v, x, y); v = (int)(x + y);
    pl32((unsigned)v, (unsigned)v, x, y); v = (int)(x + y);
    return v;
}
__device__ __forceinline__ int lane_prefix(unsigned long long mask) { return __builtin_amdgcn_mbcnt_hi((unsigned)(mask >> 32), __builtin_amdgcn_mbcnt_lo((unsigned)mask, 0)); }
__device__ __forceinline__ void rope_cs(float ang, float& c, float& s) {
    double rev = (double)ang * 0.15915494309189535; rev -= __builtin_rint(rev); const float rf = (float)rev;
    s = __builtin_amdgcn_sinf(rf); c = __builtin_amdgcn_cosf(rf);
}

__device__ __forceinline__ u32x2 to_fp8x8(const float (&o)[8]) {
    u32x2 w; int t0 = __builtin_amdgcn_cvt_pk_fp8_f32(o[0], o[1], 0, false); t0 = __builtin_amdgcn_cvt_pk_fp8_f32(o[2], o[3], t0, true);
    int t1 = __builtin_amdgcn_cvt_pk_fp8_f32(o[4], o[5], 0, false); t1 = __builtin_amdgcn_cvt_pk_fp8_f32(o[6], o[7], t1, true); w.x = (unsigned)t0; w.y = (unsigned)t1; return w;
}

template <int MODE> struct Epi {
    static constexpr bool PERM = true, AFTER_DRAIN = false;
    bf16_t* ob; float* of; const bf16_t* aux; const float* vec; const float* xsrc; float scale; const float* vec2; float* rs;
    __device__ __forceinline__ void operator()(const f32x4 (&acc)[2][2][4][2], const pg8::Unit& u, int wr, int wc, int fr, int fq) const {
        const int row0 = u.pm * 256 + wr * 64 + fr, col0 = u.pn * 256 + wc * 32 + 8 * fq;
#pragma unroll
        for (int ai = 0; ai < 2; ++ai)
#pragma unroll
            for (int m = 0; m < 4; ++m) {
                const size_t row = (size_t)(row0 + ai * 128 + m * 16);
                float ssq = 0.f, rstd = 1.f;
                if constexpr (MODE == 8) rstd = 1.f / sqrtf(rs[row] * (1.f / DM) + EPS);
#pragma unroll
                for (int bj = 0; bj < 2; ++bj) {
                    const int col = col0 + bj * 128;
                    f32x4 v0 = acc[ai][bj][m][0], v1 = acc[ai][bj][m][1];
                    if constexpr (MODE == 0 || MODE == 1) { v0 = v0 * scale; v1 = v1 * scale; }
                    if constexpr (MODE == 6) { float* p = of + row * IDXW + col; *(f32x4*)p = v0; *(f32x4*)(p + 4) = v1; }
                    else if constexpr (MODE == 0) {
                        u32x4 w; w.x = pk2(v0[0], v0[1]); w.y = pk2(v0[2], v0[3]); w.z = pk2(v1[0], v1[1]); w.w = pk2(v1[2], v1[3]);
                        *(u32x4*)(ob + row * QKVW + col) = w;
                    } else if constexpr (MODE == 1) {
                        const f32x4 b0 = *(const f32x4*)(vec + col), b1 = *(const f32x4*)(vec + col + 4);
                        float r[8];
#pragma unroll
                        for (int i = 0; i < 4; ++i) { r[i] = 1.f / (1.f + __expf(-(v0[i] + b0[i]))); r[4 + i] = 1.f / (1.f + __expf(-(v1[i] + b1[i]))); }
                        u32x4 w; w.x = pk2(r[0], r[1]); w.y = pk2(r[2], r[3]); w.z = pk2(r[4], r[5]); w.w = pk2(r[6], r[7]);
                        *(u32x4*)(ob + row * 4096 + col) = w;
                    } else if constexpr (MODE == 2 || MODE == 3) {
                        const u32x4 g = *(const u32x4*)(aux + row * 4096 + (MODE == 3 ? 2048 : 0) + col);
                        float r[8] = {v0[0], v0[1], v0[2], v0[3], v1[0], v1[1], v1[2], v1[3]};
                        const unsigned gw[4] = {g.x, g.y, g.z, g.w};
#pragma unroll
                        for (int i = 0; i < 4; ++i) { r[2 * i] *= bf2f(gw[i] & 0xffffu); r[2 * i + 1] *= __builtin_bit_cast(float, gw[i] & 0xffff0000u); }
                        if constexpr (MODE == 3) { const u32x4 pv = *(const u32x4*)(ob + row * 2048 + col); const unsigned pw[4] = {pv.x, pv.y, pv.z, pv.w};
#pragma unroll
                            for (int i = 0; i < 4; ++i) { r[2 * i] += bf2f(pw[i] & 0xffffu); r[2 * i + 1] += __builtin_bit_cast(float, pw[i] & 0xffff0000u); } }
                        u32x4 w; w.x = pk2(r[0], r[1]); w.y = pk2(r[2], r[3]); w.z = pk2(r[4], r[5]); w.w = pk2(r[6], r[7]);
                        *(u32x4*)(ob + row * 2048 + col) = w;
                    } else if constexpr (MODE == 4) {
                        const f32x4 g0 = *(const f32x4*)(vec + col), g1 = *(const f32x4*)(vec + col + 4);
                        const f32x4 x0 = *(const f32x4*)(xsrc + row * DM + col), x1 = *(const f32x4*)(xsrc + row * DM + col + 4);
                        *(f32x4*)(of + row * DM + col) = x0 + g0 * v0; *(f32x4*)(of + row * DM + col + 4) = x1 + g1 * v1;
                    } else if constexpr (MODE == 7) {
                        const f32x4 g0 = *(const f32x4*)(vec + col), g1 = *(const f32x4*)(vec + col + 4);
                        const f32x4 x0 = *(const f32x4*)(xsrc + row * DM + col), x1 = *(const f32x4*)(xsrc + row * DM + col + 4);
                        const f32x4 y0 = x0 + g0 * v0, y1 = x1 + g1 * v1;
                        *(f32x4*)(of + row * DM + col) = y0; *(f32x4*)(of + row * DM + col + 4) = y1;
                        ssq += (y0[0] * y0[0] + y0[1] * y0[1]) + (y0[2] * y0[2] + y0[3] * y0[3]) + (y1[0] * y1[0] + y1[1] * y1[1]) + (y1[2] * y1[2] + y1[3] * y1[3]);
                        const f32x4 s0 = *(const f32x4*)(vec2 + col) + 1.f, s1 = *(const f32x4*)(vec2 + col + 4) + 1.f;
                        const f32x4 a0 = y0 * s0, a1 = y1 * s1;
                        u32x4 w; w.x = pk2(a0[0], a0[1]); w.y = pk2(a0[2], a0[3]); w.z = pk2(a1[0], a1[1]); w.w = pk2(a1[2], a1[3]);
                        *(u32x4*)(ob + row * DM + col) = w;
                    } else if constexpr (MODE == 8) {
                        const f32x4 b0 = *(const f32x4*)(vec + col), b1 = *(const f32x4*)(vec + col + 4);
                        float r[8] = {v0[0] * rstd + b0[0], v0[1] * rstd + b0[1], v0[2] * rstd + b0[2], v0[3] * rstd + b0[3], v1[0] * rstd + b1[0], v1[1] * rstd + b1[1], v1[2] * rstd + b1[2], v1[3] * rstd + b1[3]};
#pragma unroll
                        for (int i = 0; i < 8; ++i) { const float q = fmaxf(r[i], 0.f); r[i] = q * q; }
                        u32x4 w; w.x = pk2(r[0], r[1]); w.y = pk2(r[2], r[3]); w.z = pk2(r[4], r[5]); w.w = pk2(r[6], r[7]);
                        *(u32x4*)(ob + row * HIDN + col) = w;
                    } else {
                        float r[8] = {v0[0], v0[1], v0[2], v0[3], v1[0], v1[1], v1[2], v1[3]};
#pragma unroll
                        for (int i = 0; i < 8; ++i) { const float q = fmaxf(r[i], 0.f); r[i] = q * q; }
                        u32x4 w; w.x = pk2(r[0], r[1]); w.y = pk2(r[2], r[3]); w.z = pk2(r[4], r[5]); w.w = pk2(r[6], r[7]);
                        *(u32x4*)(ob + row * HIDN + col) = w;
                    }
                }
                if constexpr (MODE == 7) {
                    ssq = swap16_sum(ssq, ssq); ssq = swap32_sum(ssq, ssq);
                    if (fq == 0) (void)__hip_atomic_fetch_add(rs + row, ssq, __ATOMIC_RELAXED, __HIP_MEMORY_SCOPE_AGENT);
                }
            }
    }
};

template <int MODE, bool F8 = false>
__device__ __forceinline__ void run_gemm(LAS unsigned char* lds, const void* A, const void* Bt, int N, int K, const Epi<MODE>& E, int rot = 0) {
    pg8::Gemm g{(const bf16_t*)A, (const bf16_t*)Bt, SEQ, N, K}; pg8::StaticOrder S; S.init(SEQ, N, (int)gridDim.x, (int)((blockIdx.x + rot) % gridDim.x));
    pg8::gemm_phase<Epi<MODE>, pg8::StaticOrder, true, true, F8>(lds, g, S, E);
}

template <bool F8>
__device__ __forceinline__ void transpose_item(const float* W, int ldw, int K, int N, int Npad, void* WTv, LAS float* scr, int item, int lane) {
    const int nblk = Npad / 32, kb = item / nblk, nb = item % nblk, k0 = 64 * kb, n0 = 32 * nb;
    const int c4 = (lane & 7) * 4; const bool ok = (n0 + c4) < N;
    f32x4 tv[8];
#pragma unroll
    for (int i = 0; i < 8; ++i) { const int kk = 8 * i + (lane >> 3); tv[i] = ok ? *(const f32x4*)(W + (size_t)(k0 + kk) * ldw + n0 + c4) : (f32x4){0.f, 0.f, 0.f, 0.f}; }
#pragma unroll
    for (int i = 0; i < 8; ++i) { const int kk = 8 * i + (lane >> 3); LAS float* d = scr + kk * 33 + c4; d[0] = tv[i][0]; d[1] = tv[i][1]; d[2] = tv[i][2]; d[3] = tv[i][3]; }
    asm volatile("s_waitcnt lgkmcnt(0)" ::: "memory");
    const int c = lane & 7;
#pragma unroll
    for (int j = 0; j < 4; ++j) { const int n = (lane >> 3) + 8 * j; const LAS float* s = scr + (8 * c) * 33 + n;
        if constexpr (F8) { const float x[8] = {s[0] * W8_SCALE, s[33] * W8_SCALE, s[66] * W8_SCALE, s[99] * W8_SCALE, s[132] * W8_SCALE, s[165] * W8_SCALE, s[198] * W8_SCALE, s[231] * W8_SCALE};
            *(u32x2*)((unsigned char*)WTv + (size_t)(n0 + n) * K + k0 + 8 * c) = to_fp8x8(x); }
        else { u32x4 o; o.x = pk2(s[0 * 33], s[1 * 33]); o.y = pk2(s[2 * 33], s[3 * 33]); o.z = pk2(s[4 * 33], s[5 * 33]); o.w = pk2(s[6 * 33], s[7 * 33]);
            *(u32x4*)((bf16_t*)WTv + (size_t)(n0 + n) * K + k0 + 8 * c) = o; } }
    asm volatile("s_waitcnt lgkmcnt(0)" ::: "memory");
}

__device__ __forceinline__ void mod_item(const float* c, const float* w_ada, const float* b_ada, float* mod, LAS float* red, int it, int tid) {
    const int l = it / 384, n0 = (it % 384) * 32, cl = tid & 7, kg = tid >> 3;
    const float* W = w_ada + (size_t)l * DM * NMOD + n0 + 4 * cl;
    f32x4 a0 = {0.f, 0.f, 0.f, 0.f}, a1 = {0.f, 0.f, 0.f, 0.f};
#pragma unroll 16
    for (int k = kg * 32; k < kg * 32 + 32; ++k) {
        const f32x4 w = *(const f32x4*)(W + (size_t)k * NMOD); float c0 = c[k], c1 = c[DM + k];
        c0 = c0 / (1.f + __expf(-c0)); c1 = c1 / (1.f + __expf(-c1)); a0 += w * c0; a1 += w * c1; }
#pragma unroll
    for (int e = 0; e < 4; ++e) { red[(kg * 2 + 0) * 32 + 4 * cl + e] = a0[e]; red[(kg * 2 + 1) * 32 + 4 * cl + e] = a1[e]; }
    __syncthreads();
    if (tid < 64) { const int b = tid >> 5, col = tid & 31; float s = 0.f;
#pragma unroll 16
        for (int g = 0; g < 64; ++g) s += red[(g * 2 + b) * 32 + col];
        mod[((size_t)l * 2 + b) * NMOD + n0 + col] = s + b_ada[(size_t)l * NMOD + n0 + col]; }
    __syncthreads();
}

template <bool F8>
__device__ __forceinline__ void norm_row(const float* xrow, const float* sh, const float* sc, bf16_t* hrow, unsigned char* h8row, int lane) {
    f32x4 v[8]; float ss = 0.f;
#pragma unroll
    for (int j = 0; j < 8; ++j) { v[j] = ((const f32x4*)xrow)[lane + 64 * j]; ss += (v[j].x * v[j].x + v[j].y * v[j].y) + (v[j].z * v[j].z + v[j].w * v[j].w); }
    ss = wave_sum(ss); const float r = 1.f / sqrtf(ss * (1.f / DM) + EPS);
#pragma unroll
    for (int j = 0; j < 8; ++j) { const f32x4 s4 = ((const f32x4*)sc)[lane + 64 * j], h4 = ((const f32x4*)sh)[lane + 64 * j];
        const f32x4 y = v[j] * r * (s4 + 1.f) + h4; u32x2 o; o.x = pk2(y.x, y.y); o.y = pk2(y.z, y.w); ((u32x2*)hrow)[lane + 64 * j] = o;
        if constexpr (F8) { int t0 = __builtin_amdgcn_cvt_pk_fp8_f32(y.x, y.y, 0, false); t0 = __builtin_amdgcn_cvt_pk_fp8_f32(y.z, y.w, t0, true); ((unsigned*)h8row)[lane + 64 * j] = (unsigned)t0; } }
}

__device__ __forceinline__ float row16_sum(float v) { v += dpp_f<0x128>(v); v += dpp_f<0x124>(v); v += dpp_f<0x4E>(v); v += dpp_f<0xB1>(v); return v; }
template <int NIT>
__device__ __forceinline__ void post_load(u32x4 (&raw)[NIT], const bf16_t* seg, int c, int grp) {
#pragma unroll
    for (int it = 0; it < NIT; ++it) raw[it] = *(const u32x4*)(seg + (it * 4 + grp) * 128 + c * 8);
}
template <int NIT, bool F8>
__device__ __forceinline__ void post_segment(bf16_t* seg, const u32x4 (&raw)[NIT], const f32x4 g0, const f32x4 g1, const float (&cs)[8], const float (&sn)[8], int c, int grp, unsigned char* k8 = nullptr) {
    const float g[8] = {g0[0], g0[1], g0[2], g0[3], g1[0], g1[1], g1[2], g1[3]};
#pragma unroll
    for (int it = 0; it < NIT; ++it) {
        const unsigned w[4] = {raw[it].x, raw[it].y, raw[it].z, raw[it].w}; float x[8];
#pragma unroll
        for (int i = 0; i < 4; ++i) { x[2 * i] = bf2f(w[i] & 0xffffu); x[2 * i + 1] = __builtin_bit_cast(float, w[i] & 0xffff0000u); }
        float ss = 0.f;
#pragma unroll
        for (int e = 0; e < 8; ++e) ss += x[e] * x[e];
        ss = row16_sum(ss); const float r = 1.f / sqrtf(ss * (1.f / 128.f) + EPS);
        float o[8];
#pragma unroll
        for (int e = 0; e < 8; ++e) { const float y = x[e] * r * g[e]; const float py = dpp_f<0x128>(y); o[e] = y * cs[e] + py * sn[e]; }
        u32x4 ow; ow.x = pk2(o[0], o[1]); ow.y = pk2(o[2], o[3]); ow.z = pk2(o[4], o[5]); ow.w = pk2(o[6], o[7]);
        *(u32x4*)(seg + (it * 4 + grp) * 128 + c * 8) = ow;
        if constexpr (F8) *(u32x2*)(k8 + (it * 4 + grp) * 128 + c * 8) = to_fp8x8(o);
    }
}
__device__ __forceinline__ void post_token(int pos, const float* gaq, const float* gak, const float* gbq, const float* gbk, const float* gik,
                                           bf16_t* qrow, const float* irow, bf16_t* iq, bf16_t* ik, float* iw, unsigned char* k8, unsigned char* v8, int lane) {
    const float pf = (float)pos; const int c = lane & 15, grp = lane >> 4; const float sgn = (c < 8) ? -1.f : 1.f;
    u32x4 r_aq[3], r_ak[3], r_bq[2], r_bk[2], r_bv[2]; f32x4 xi[4];
    post_load<3>(r_aq, qrow + COL_AQ, c, grp); post_load<3>(r_ak, qrow + COL_AK, c, grp); post_load<2>(r_bq, qrow + COL_BQ, c, grp); post_load<2>(r_bk, qrow + COL_BK, c, grp); post_load<2>(r_bv, qrow + COL_BV, c, grp);
#pragma unroll
    for (int it = 0; it < 4; ++it) xi[it] = *(const f32x4*)(irow + (it * 4 + grp) * 64 + 4 * c);
    const f32x4 xk = *(const f32x4*)(irow + 1024 + 4 * c); const float iwv = irow[1088 + (lane & 15)];
    const f32x4 gaq0 = *(const f32x4*)(gaq + 8 * c), gaq1 = *(const f32x4*)(gaq + 8 * c + 4), gak0 = *(const f32x4*)(gak + 8 * c), gak1 = *(const f32x4*)(gak + 8 * c + 4);
    const f32x4 gbq0 = *(const f32x4*)(gbq + 8 * c), gbq1 = *(const f32x4*)(gbq + 8 * c + 4), gbk0 = *(const f32x4*)(gbk + 8 * c), gbk1 = *(const f32x4*)(gbk + 8 * c + 4);
    const f32x4 gk = *(const f32x4*)(gik + 4 * c);
    float cs[8], sn[8];
#pragma unroll
    for (int e = 0; e < 8; ++e) { float s_; rope_cs(pf * INVF[8 * (c & 7) + e], cs[e], s_); sn[e] = s_ * sgn; }
    post_segment<3, false>(qrow + COL_AQ, r_aq, gaq0, gaq1, cs, sn, c, grp);
    post_segment<3, false>(qrow + COL_AK, r_ak, gak0, gak1, cs, sn, c, grp);
    post_segment<2, false>(qrow + COL_BQ, r_bq, gbq0, gbq1, cs, sn, c, grp);
    post_segment<2, true>(qrow + COL_BK, r_bk, gbk0, gbk1, cs, sn, c, grp, k8);
#pragma unroll
    for (int it = 0; it < 2; ++it) { const u32x4 raw = r_bv[it]; const unsigned w[4] = {raw.x, raw.y, raw.z, raw.w}; float x[8];
#pragma unroll
        for (int i = 0; i < 4; ++i) { x[2 * i] = bf2f(w[i] & 0xffffu); x[2 * i + 1] = __builtin_bit_cast(float, w[i] & 0xffff0000u); }
        *(u32x2*)(v8 + (it * 4 + grp) * 128 + c * 8) = to_fp8x8(x); }
    float ci[4], si[4];
#pragma unroll
    for (int e = 0; e < 4; ++e) { float s_; rope_cs(pf * INVF[2 * ((4 * c + e) & 31)], ci[e], s_); si[e] = s_ * sgn; }
#pragma unroll
    for (int it = 0; it < 4; ++it) { float o[4];
#pragma unroll
        for (int e = 0; e < 4; ++e) { const float x = xi[it][e]; const float px = dpp_f<0x128>(x); o[e] = x * ci[e] + px * si[e]; }
        u32x2 ow; ow.x = pk2(o[0], o[1]); ow.y = pk2(o[2], o[3]); *(u32x2*)(iq + (it * 4 + grp) * 64 + 4 * c) = ow; }
    { float ss = (xk[0] * xk[0] + xk[1] * xk[1]) + (xk[2] * xk[2] + xk[3] * xk[3]); ss = row16_sum(ss); const float r = 1.f / sqrtf(ss * (1.f / 64.f) + EPS);
      float o[4];
#pragma unroll
      for (int e = 0; e < 4; ++e) { const float y = xk[e] * r * gk[e]; const float py = dpp_f<0x128>(y); o[e] = y * ci[e] + py * si[e]; }
      if (grp == 0) { u32x2 ow; ow.x = pk2(o[0], o[1]); ow.y = pk2(o[2], o[3]); *(u32x2*)(ik + 4 * c) = ow; } }
    if (lane < 16) iw[lane] = iwv * 0.25f;
}

typedef float f32x2_t __attribute__((ext_vector_type(2)));
__device__ __forceinline__ void s8_issue_k(long (&kf)[16], const unsigned char* K8h, LAS const int* wsel, int j0, int n16, int slab) {
#pragma unroll
    for (int g = 0; g < 4; ++g) { const unsigned char* kp = K8h + (size_t)wsel[j0 + 16 * g + n16] * 1024 + 16 * slab;
        const u32x4 lo = *(const u32x4*)kp, hi = *(const u32x4*)(kp + 64);
        kf[g * 4 + 0] = (long)(((unsigned long long)lo.y << 32) | lo.x); kf[g * 4 + 1] = (long)(((unsigned long long)lo.w << 32) | lo.z);
        kf[g * 4 + 2] = (long)(((unsigned long long)hi.y << 32) | hi.x); kf[g * 4 + 3] = (long)(((unsigned long long)hi.w << 32) | hi.z); }
}
template <int Q> __device__ __forceinline__ void s9_issue_v(unsigned (&vv)[8], const unsigned char* V8h, LAS const unsigned* otw, int half, int l4) {
#pragma unroll
    for (int u2 = 0; u2 < 8; ++u2) vv[u2] = *(const unsigned*)(V8h + (otw[2 * (Q * 8 + u2) + half] | (unsigned)l4));
}
template <int Q> __device__ __forceinline__ void s9_pv(const unsigned (&vv)[8], LAS const float* ptw, int half, f32x2_t& oa, f32x2_t& ob) {
#pragma unroll
    for (int u2 = 0; u2 < 8; ++u2) { const float p = ptw[2 * (Q * 8 + u2) + half];
        oa = __builtin_amdgcn_cvt_pk_f32_fp8((int)vv[u2], false) * p + oa; ob = __builtin_amdgcn_cvt_pk_f32_fp8((int)vv[u2], true) * p + ob; }
}
__device__ __forceinline__ void sparse_unit7(const bf16_t* QKV, const unsigned char* K8, const unsigned char* V8, const int (&selv)[4], bf16_t* OB, LAS unsigned char* wl, int t, int h, int lane) {
    LAS int* wsel = (LAS int*)wl; LAS unsigned* otw = (LAS unsigned*)(wl + 1024); LAS float* ptw = (LAS float*)(wl + 2048);
    const int n16 = lane & 15, slab = lane >> 4, half = lane >> 5, l4 = (lane & 31) * 4;
    const bf16_t* qrow = QKV + (size_t)t * QKVW + COL_BQ + h * 128 + 16 * slab;
    long qa[4];
#pragma unroll
    for (int ks = 0; ks < 4; ++ks) { const u32x4 raw = *(const u32x4*)(qrow + 8 * (ks & 1) + 64 * (ks >> 1)); const unsigned w[4] = {raw.x, raw.y, raw.z, raw.w}; float x[8];
#pragma unroll
        for (int i = 0; i < 4; ++i) { x[2 * i] = bf2f(w[i] & 0xffffu); x[2 * i + 1] = __builtin_bit_cast(float, w[i] & 0xffff0000u); }
        const u32x2 f = to_fp8x8(x); qa[ks] = (long)(((unsigned long long)f.y << 32) | f.x); }
    const unsigned char* K8h = K8 + h * 128; const unsigned char* V8h = V8 + h * 128;
    const int n = min(256, t + 1), ns = (n + 63) >> 6;
#pragma unroll
    for (int s = 0; s < 4; ++s) { const int j = 64 * s + lane; const int id = (j < n) ? selv[s] : 0; wsel[j] = id; otw[j] = (unsigned)id * 1024u; }
    asm volatile("" ::: "memory");
    long kf[16]; unsigned va[8], vb[8];
    s8_issue_k(kf, K8h, wsel, 0, n16, slab);
    s9_issue_v<0>(va, V8h, otw, half, l4);
    float m = -INFINITY, l = 0.f; f32x2_t oa = {0.f, 0.f}, ob = {0.f, 0.f};
#pragma unroll
    for (int s = 0; s < 4; ++s) {
        if (s < ns) {
            const bool valid = (64 * s + lane) < n;
            LAS const unsigned* ot = otw + 64 * s; LAS float* pt = ptw + 64 * s;
            s9_issue_v<1>(vb, V8h, ot, half, l4);
            f32x4 acc[4];
#pragma unroll
            for (int g = 0; g < 4; ++g) { acc[g] = (f32x4){0.f, 0.f, 0.f, 0.f};
#pragma unroll
                for (int ks = 0; ks < 4; ++ks) acc[g] = __builtin_amdgcn_mfma_f32_16x16x32_fp8_fp8(qa[ks], kf[g * 4 + ks], acc[g], 0, 0, 0); }
            float sc = (slab == 0) ? acc[0][0] : (slab == 1) ? acc[1][0] : (slab == 2) ? acc[2][0] : acc[3][0];
            sc = valid ? sc * 0.08838834764831845f : -INFINITY;
            const float mn = fmaxf(m, wave_max(sc));
            const float alpha = __expf(m - mn), p = __expf(sc - mn);
            oa = oa * alpha; ob = ob * alpha; m = mn; l = l * alpha + p;
            pt[lane] = p;
            asm volatile("" ::: "memory");
            const int sn_ = (s < 3) ? (s + 1) : 3;
            s8_issue_k(kf, K8h, wsel, 64 * sn_, n16, slab);
            s9_pv<0>(va, pt, half, oa, ob);
            s9_issue_v<2>(va, V8h, ot, half, l4);
            s9_pv<1>(vb, pt, half, oa, ob);
            s9_issue_v<3>(vb, V8h, ot, half, l4);
            s9_pv<2>(va, pt, half, oa, ob);
            s9_issue_v<0>(va, V8h, otw + 64 * sn_, half, l4);
            s9_pv<3>(vb, pt, half, oa, ob);
        }
    }
    const float inv = 1.f / wave_sum(l);
    const float r0 = swap32_sum(oa.x, oa.x), r1 = swap32_sum(oa.y, oa.y), r2 = swap32_sum(ob.x, ob.x), r3 = swap32_sum(ob.y, ob.y);
    if (half == 0) { u32x2 o; o.x = pk2(r0 * inv, r1 * inv); o.y = pk2(r2 * inv, r3 * inv); *(u32x2*)(OB + (size_t)t * 1024 + h * 128 + l4) = o; }
    asm volatile("" ::: "memory");
}

typedef short v4i16_t __attribute__((ext_vector_type(4)));
constexpr int VRS = 272;
__device__ __forceinline__ void dilated_block(const bf16_t* QKV, bf16_t* OG, float* LSE, LAS unsigned char* lds, int u, int tid) {
    const int lane = tid & 63, wave = __builtin_amdgcn_readfirstlane(tid >> 6), n16 = lane & 15, slab = lane >> 4;
    const int g = u >> 9, rem = u & 511, hs = rem >> 7, pn = rem & 127;
    const int rsh = 2 * g, nbk = 128 >> rsh, p = pn >> (7 - rsh), nb = pn & (nbk - 1);
    const int head = g * 4 + hs, mbase = 128 * (nb - 1);
    __syncthreads();
#pragma unroll
    for (int i = 0; i < 8; ++i) { const int c = tid + 512 * i, row = c >> 4, ch = c & 15, m = mbase + row; u32x4 v = {0u, 0u, 0u, 0u};
        if (m >= 0) v = *(const u32x4*)(QKV + (size_t)((m << rsh) + p) * QKVW + COL_AV + head * 128 + ch * 8);
        *(LAS u32x4*)(lds + row * VRS + ch * 16) = v; }
    __syncthreads();
    const int i0 = wave * 16;
    const int tq = ((mbase + 128 + i0 + n16) << rsh) + p;
    bf16x8 qf[4];
#pragma unroll
    for (int ks = 0; ks < 4; ++ks) qf[ks] = *(const bf16x8*)(QKV + (size_t)tq * QKVW + COL_AQ + head * 128 + ks * 32 + slab * 8);
    f32x4 sacc[10];
#pragma unroll
    for (int jt = 0; jt < 9; ++jt) { int m = mbase + i0 + 16 * jt + n16; m = max(m, 0);
        const bf16_t* kp = QKV + (size_t)((m << rsh) + p) * QKVW + COL_AK + head * 128 + slab * 8;
        f32x4 acc = {0.f, 0.f, 0.f, 0.f};
#pragma unroll
        for (int ks = 0; ks < 4; ++ks) acc = __builtin_amdgcn_mfma_f32_16x16x32_bf16(*(const bf16x8*)(kp + ks * 32), qf[ks], acc, 0, 0, 0);
        sacc[jt] = acc; }
    float mx = -INFINITY;
#pragma unroll
    for (int jt = 0; jt < 9; ++jt)
#pragma unroll
        for (int i = 0; i < 4; ++i) { const int d = 128 + n16 - 16 * jt - 4 * slab - i, kk = i0 + 16 * jt + 4 * slab + i;
            const bool ok = (d >= 0) && (d <= 128) && (nb > 0 || kk >= 128);
            const float s = ok ? sacc[jt][i] * 0.08838834764831845f : -INFINITY; sacc[jt][i] = s; mx = fmaxf(mx, s); }
    { unsigned x, y; pl16(__builtin_bit_cast(unsigned, mx), __builtin_bit_cast(unsigned, mx), x, y); mx = fmaxf(__builtin_bit_cast(float, x), __builtin_bit_cast(float, y));
      pl32(__builtin_bit_cast(unsigned, mx), __builtin_bit_cast(unsigned, mx), x, y); mx = fmaxf(__builtin_bit_cast(float, x), __builtin_bit_cast(float, y)); }
    float lsum = 0.f;
#pragma unroll
    for (int jt = 0; jt < 9; ++jt)
#pragma unroll
        for (int i = 0; i < 4; ++i) { const float pe = __expf(sacc[jt][i] - mx); sacc[jt][i] = pe; lsum += pe; }
    sacc[9] = (f32x4){0.f, 0.f, 0.f, 0.f};
    lsum = swap16_sum(lsum, lsum); lsum = swap32_sum(lsum, lsum);
    if (slab == 0) LSE[(size_t)tq * 12 + head] = mx + __logf(lsum);
    f32x4 oacc[8];
#pragma unroll
    for (int c = 0; c < 8; ++c) oacc[c] = (f32x4){0.f, 0.f, 0.f, 0.f};
    const int q4 = n16 >> 2, p4 = lane & 3;
#pragma unroll
    for (int u2 = 0; u2 < 5; ++u2) {
        u32x4 pw; pw.x = pk2(sacc[2 * u2][0], sacc[2 * u2][1]); pw.y = pk2(sacc[2 * u2][2], sacc[2 * u2][3]); pw.z = pk2(sacc[2 * u2 + 1][0], sacc[2 * u2 + 1][1]); pw.w = pk2(sacc[2 * u2 + 1][2], sacc[2 * u2 + 1][3]);
        const bf16x8 pf = __builtin_bit_cast(bf16x8, pw);
        const int r0 = min(i0 + 32 * u2 + 4 * slab + q4, 255), r1 = min(i0 + 32 * u2 + 16 + 4 * slab + q4, 255);
        LAS unsigned char* a0p = lds + r0 * VRS + 8 * p4; LAS unsigned char* a1p = lds + r1 * VRS + 8 * p4;
#pragma unroll
        for (int c = 0; c < 8; ++c) {
            const v4i16_t lo = __builtin_amdgcn_ds_read_tr16_b64_v4i16((LAS v4i16_t*)(a0p + c * 32)), hi = __builtin_amdgcn_ds_read_tr16_b64_v4i16((LAS v4i16_t*)(a1p + c * 32));
            const bf16x8 vf = __builtin_shufflevector(lo, hi, 0, 1, 2, 3, 4, 5, 6, 7);
            oacc[c] = __builtin_amdgcn_mfma_f32_16x16x32_bf16(vf, pf, oacc[c], 0, 0, 0);
        }
    }
    const float inv = 1.f / lsum;
    bf16_t* op = OG + ((size_t)g * SEQ + tq) * 512 + hs * 128 + 4 * slab;
#pragma unroll
    for (int c = 0; c < 8; ++c) { u32x2 o; o.x = pk2(oacc[c][0] * inv, oacc[c][1] * inv); o.y = pk2(oacc[c][2] * inv, oacc[c][3] * inv); *(u32x2*)(op + 16 * c) = o; }
}
__device__ __forceinline__ void dilated_merge(const bf16_t* OG, const float* LSE, bf16_t* OA, int t, int hs, int lane) {
    const float l0 = LSE[(size_t)t * 12 + hs], l1 = LSE[(size_t)t * 12 + 4 + hs], l2 = LSE[(size_t)t * 12 + 8 + hs];
    const float mx = fmaxf(l0, fmaxf(l1, l2)); float w0 = __expf(l0 - mx), w1 = __expf(l1 - mx), w2 = __expf(l2 - mx);
    const float inv = 1.f / (w0 + w1 + w2); w0 *= inv; w1 *= inv; w2 *= inv;
    const size_t off = (size_t)t * 512 + hs * 128 + 2 * lane;
    const unsigned v0 = *(const unsigned*)(OG + off), v1 = *(const unsigned*)(OG + (size_t)SEQ * 512 + off), v2 = *(const unsigned*)(OG + (size_t)2 * SEQ * 512 + off);
    const float o0 = w0 * bf2f(v0 & 0xffffu) + w1 * bf2f(v1 & 0xffffu) + w2 * bf2f(v2 & 0xffffu);
    const float o1 = w0 * __builtin_bit_cast(float, v0 & 0xffff0000u) + w1 * __builtin_bit_cast(float, v1 & 0xffff0000u) + w2 * __builtin_bit_cast(float, v2 & 0xffff0000u);
    *(unsigned*)(OA + off) = pk2(o0, o1);
}

constexpr int ICAP = 512, NQI = 4;
__device__ __forceinline__ unsigned f2sort(float f) { const unsigned b = __builtin_bit_cast(unsigned, f); return b ^ ((b & 0x80000000u) ? 0xffffffffu : 0x80000000u); }
__device__ __forceinline__ float sort2f(unsigned u) { return __builtin_bit_cast(float, u ^ ((u & 0x80000000u) ? 0x80000000u : 0xffffffffu)); }
__device__ __forceinline__ void idx_compact(LAS float* bs, LAS unsigned* bi, int& cnt, float& tau, int lane) {
    unsigned u[ICAP / 64], id[ICAP / 64];
#pragma unroll
    for (int i = 0; i < ICAP / 64; ++i) { const int e = i * 64 + lane; const bool in = e < cnt; u[i] = in ? f2sort(bs[e]) : 0u; id[i] = in ? bi[e] : 0u; }
    unsigned T = 0u;
#pragma unroll 1
    for (int bit = 31; bit >= 0; --bit) { const unsigned cand = T | (1u << bit); int c = 0;
#pragma unroll
        for (int i = 0; i < ICAP / 64; ++i) c += __popcll(__ballot(u[i] >= cand));
        if (c >= 256) T = cand; if (c == 256) break; }
    int ngt = 0;
#pragma unroll
    for (int i = 0; i < ICAP / 64; ++i) ngt += __popcll(__ballot(u[i] > T));
    const int need_eq = 256 - ngt;
    int base = 0, eqbase = 0;
    __builtin_amdgcn_wave_barrier();
#pragma unroll
    for (int i = 0; i < ICAP / 64; ++i) {
        const bool gt = u[i] > T, eq = u[i] == T;
        const unsigned long long em = __ballot(eq); const int eqpos = eqbase + lane_prefix(em); eqbase += __popcll(em);
        const bool keep = gt || (eq && eqpos < need_eq);
        const unsigned long long km = __ballot(keep); const int pos = base + lane_prefix(km); base += __popcll(km);
        if (keep) { bs[pos] = sort2f(u[i]); bi[pos] = id[i]; }
    }
    __builtin_amdgcn_wave_barrier();
    cnt = 256; tau = sort2f(T);
}
__device__ __forceinline__ void idx_load(bf16x8 (&f)[8], const bf16_t* IK, int kb, int n16, int slab) {
#pragma unroll
    for (int g = 0; g < 4; ++g) { const bf16_t* kp = IK + (size_t)(kb * 64 + g * 16 + n16) * 64 + slab * 8; f[2 * g] = *(const bf16x8*)kp; f[2 * g + 1] = *(const bf16x8*)(kp + 32); }
}
__device__ __forceinline__ void idx_wait8(bf16x8 (&)[8]) {}
__device__ __forceinline__ void idx_wait0(bf16x8 (&)[8], bf16x8 (&)[8]) {}
typedef _Float16 h2_t __attribute__((ext_vector_type(2)));
typedef _Float16 h4_t __attribute__((ext_vector_type(4)));
__device__ __forceinline__ float idx_score(const bf16x8 (&f)[8], const bf16x8 a0, const bf16x8 a1, const h4_t (&wa)[4]) {
    f32x4 s = {0.f, 0.f, 0.f, 0.f}; const h2_t z = {(_Float16)0, (_Float16)0};
#pragma unroll
    for (int g = 0; g < 4; ++g) {
        f32x4 acc = {0.f, 0.f, 0.f, 0.f};
        acc = __builtin_amdgcn_mfma_f32_16x16x32_bf16(a0, f[2 * g], acc, 0, 0, 0);
        acc = __builtin_amdgcn_mfma_f32_16x16x32_bf16(a1, f[2 * g + 1], acc, 0, 0, 0);
        h2_t lo = {(_Float16)acc[0], (_Float16)acc[1]}, hi = {(_Float16)acc[2], (_Float16)acc[3]};
        lo = __builtin_elementwise_max(lo, z); hi = __builtin_elementwise_max(hi, z);
        const h4_t bb = {lo[0], lo[1], hi[0], hi[1]};
        s = __builtin_amdgcn_mfma_f32_16x16x16f16(wa[g], bb, s, 0, 0, 0);
    }
    return s[0];
}
__device__ __forceinline__ void idx_append(float score, LAS float* bs, LAS unsigned* bi, int& cnt, float& tau, int kb, int t, int lane) {
    const int kidx = kb * 64 + lane;
    const bool valid = (kidx <= t) && (score > tau);
    const unsigned long long vm = __ballot(valid); const int pos = cnt + lane_prefix(vm);
    if (valid) { bs[pos] = score; bi[pos] = (unsigned)kidx; }
    cnt += __popcll(vm);
    __builtin_amdgcn_wave_barrier();
    if (cnt > ICAP - 64) idx_compact(bs, bi, cnt, tau, lane);
}
__device__ __forceinline__ void indexer_unit(const bf16_t* IQ, const bf16_t* IK, const float* IW, unsigned short* SEL, LAS unsigned char* wlds, int t0, int lane) {
    const int n16 = lane & 15, slab = lane >> 4;
    bf16x8 a0[NQI], a1[NQI]; h4_t wa[NQI][4]; int cnt[NQI]; float tau[NQI];
#pragma unroll
    for (int q = 0; q < NQI; ++q) { const size_t t = (size_t)(t0 + q);
        a0[q] = *(const bf16x8*)(IQ + t * 1024 + n16 * 64 + slab * 8); a1[q] = *(const bf16x8*)(IQ + t * 1024 + n16 * 64 + 32 + slab * 8);
        const f32x4 wv = *(const f32x4*)(IW + t * 16 + slab * 4); const h4_t wh = {(_Float16)wv[0], (_Float16)wv[1], (_Float16)wv[2], (_Float16)wv[3]};
        const h4_t hz = {(_Float16)0, (_Float16)0, (_Float16)0, (_Float16)0};
#pragma unroll
        for (int g = 0; g < 4; ++g) wa[q][g] = (n16 == 4 * g) ? wh : hz;
        cnt[q] = 0; tau[q] = -INFINITY; }
    const int nkb = t0 / 64 + 1;
#pragma unroll
    for (int q = 0; q < NQI; ++q) asm volatile("" :: "v"(a0[q]), "v"(a1[q]), "v"(wa[q][0]), "v"(wa[q][1]), "v"(wa[q][2]), "v"(wa[q][3]));
    bf16x8 fa[8], fb[8];
#pragma unroll
    for (int i = 0; i < 8; ++i) { fa[i] = (bf16x8){0, 0, 0, 0, 0, 0, 0, 0}; fb[i] = fa[i]; }
    idx_load(fa, IK, 0, n16, slab);
#pragma unroll 1
    for (int kb = 0; kb < nkb; kb += 2) {
        idx_load(fb, IK, min(kb + 1, nkb - 1), n16, slab);
        idx_wait8(fa);
        { float sc[NQI];
#pragma unroll
          for (int q = 0; q < NQI; ++q) sc[q] = idx_score(fa, a0[q], a1[q], wa[q]);
#pragma unroll
          for (int q = 0; q < NQI; ++q) idx_append(sc[q], (LAS float*)(wlds + q * 4096), (LAS unsigned*)(wlds + q * 4096 + 2048), cnt[q], tau[q], kb, t0 + q, lane); }
        idx_load(fa, IK, min(kb + 2, nkb - 1), n16, slab);
        idx_wait8(fb);
        if (kb + 1 < nkb) {
            float sc[NQI];
#pragma unroll
            for (int q = 0; q < NQI; ++q) sc[q] = idx_score(fb, a0[q], a1[q], wa[q]);
#pragma unroll
            for (int q = 0; q < NQI; ++q) idx_append(sc[q], (LAS float*)(wlds + q * 4096), (LAS unsigned*)(wlds + q * 4096 + 2048), cnt[q], tau[q], kb + 1, t0 + q, lane);
        }
    }
    idx_wait0(fa, fb);
#pragma unroll
    for (int q = 0; q < NQI; ++q) {
        LAS float* bs = (LAS float*)(wlds + q * 4096); LAS unsigned* bi = (LAS unsigned*)(wlds + q * 4096 + 2048);
        if (cnt[q] > 256) idx_compact(bs, bi, cnt[q], tau[q], lane);
        __builtin_amdgcn_wave_barrier();
        unsigned short* sel = SEL + (size_t)(t0 + q) * 256;
#pragma unroll
        for (int j = 0; j < 4; ++j) { const int e = j * 64 + lane; if (e < cnt[q]) sel[e] = (unsigned short)bi[e]; }
    }
    __builtin_amdgcn_wave_barrier();
}

#define RLX_AGENT __ATOMIC_RELAXED, __HIP_MEMORY_SCOPE_AGENT
#define XB_TMO      128
#define XB_XCNT(j)  (256  + 64 * (j))
#define XB_XSUB(j)  (1280 + 64 * (j))
#define XB_XGEN(j)  (2304 + 64 * (j))
#define XB_TOP      3328
#define XB_TOPGEN   3392
#define XCD_BAR_WORDS 3456
#define XB_SPIN_CAP (1u << 18)

__device__ __forceinline__ unsigned xb_ld(unsigned* p)              { return __hip_atomic_load(p, __ATOMIC_RELAXED, __HIP_MEMORY_SCOPE_AGENT); }
__device__ __forceinline__ unsigned xb_add(unsigned* p, unsigned v) { return __hip_atomic_fetch_add(p, v, __ATOMIC_RELAXED, __HIP_MEMORY_SCOPE_AGENT); }
__device__ __forceinline__ unsigned xb_xcc_id() { return (unsigned)__builtin_amdgcn_s_getreg((3 << 11) | 20) & 0xFu; }
#define XB_SPIN(cond, bar) do { unsigned _sp = 0; while (cond) { __builtin_amdgcn_s_sleep(1); \
    if ((++_sp & 255u) == 0u) { if (xb_ld(&(bar)[XB_TMO])) break; if (_sp > XB_SPIN_CAP) { atomicAdd(&(bar)[XB_TMO], 1u); break; } } } } while (0)

struct XcdBarrier {
    unsigned* bar; unsigned x;
    volatile LAS unsigned* st;
};

__device__ __forceinline__ XcdBarrier xcd_barrier_post(unsigned* bar, volatile LAS unsigned* st) {
    XcdBarrier b; b.bar = bar; b.x = xb_xcc_id(); b.st = st;
    if (threadIdx.x == 0) (void)xb_add(&bar[XB_XCNT(b.x)], 1u);
    return b;
}
__device__ __forceinline__ void xcd_barrier_complete(unsigned* bar, unsigned x, unsigned& nloc, unsigned& nx) {
    const unsigned G = gridDim.x * gridDim.y * gridDim.z;
    unsigned sum, cnt, mine, sp = 0u;
    for (;;) {
        sum = 0u; cnt = 0u; mine = 0u;
#pragma unroll
        for (unsigned j = 0; j < 16; ++j) { const unsigned c = xb_ld(&bar[XB_XCNT(j)]); sum += c; cnt += (c > 0u) ? 1u : 0u; mine = (j == x) ? c : mine; }
        if (sum == G) break;
        __builtin_amdgcn_s_sleep(1);
        if ((++sp & 255u) == 0u) { if (xb_ld(&bar[XB_TMO])) break; if (sp > XB_SPIN_CAP) { atomicAdd(&bar[XB_TMO], 1u); break; } }
    }
    nloc = mine > 0u ? mine : 1u; nx = cnt > 0u ? cnt : 1u;
}

__device__ __forceinline__ void xcd_barrier(const XcdBarrier& b) {
    asm volatile("s_waitcnt vmcnt(0)" ::: "memory");
    __syncthreads();
    if (threadIdx.x == 0) {
        unsigned* bar = b.bar;
        __builtin_amdgcn_s_waitcnt(0);
        unsigned nloc = b.st[0], nx = b.st[1];
        if (nloc == 0u) { xcd_barrier_complete(bar, b.x, nloc, nx); b.st[0] = nloc; b.st[1] = nx; }
        const unsigned old = xb_add(&bar[XB_XSUB(b.x)], 1u);
        const unsigned gen = old / nloc;
        if (old + 1u == (gen + 1u) * nloc) {
            __builtin_amdgcn_fence(__ATOMIC_RELEASE, "agent");
            asm volatile("s_waitcnt vmcnt(0)" ::: "memory");
            const unsigned og = xb_add(&bar[XB_TOP], 1u);
            const unsigned tg = og / nx;
            if (og + 1u == (tg + 1u) * nx) xb_add(&bar[XB_TOPGEN], 1u);
            else XB_SPIN(xb_ld(&bar[XB_TOPGEN]) == tg, bar);
            __builtin_amdgcn_fence(__ATOMIC_ACQUIRE, "agent");
            xb_add(&bar[XB_XGEN(b.x)], 1u);
            asm volatile("s_waitcnt vmcnt(0)" ::: "memory");
        } else {
            XB_SPIN(xb_ld(&bar[XB_XGEN(b.x)]) == gen, bar);
            __builtin_amdgcn_fence(__ATOMIC_ACQUIRE, "agent");
            asm volatile("s_waitcnt vmcnt(0)" ::: "memory");
        }
    }
    __syncthreads();
}

#ifndef REP_IDX
#define REP_IDX 1
#endif
#ifndef REP_DIL
#define REP_DIL 1
#endif
#ifndef REP_SP
#define REP_SP 1
#endif
#ifndef REP_POST
#define REP_POST 1
#endif
#ifndef REP_PREP
#define REP_PREP 1
#endif
#ifndef REP_P
#define REP_P 1
#endif
#ifndef REP_N
#define REP_N 1
#endif
#ifndef REP_G
#define REP_G 1
#endif
#ifndef PHMASK
#define PHMASK 0xFFFF
#endif
#define PHON(k) ((PHMASK >> (k)) & 1)
struct Args { const float* in[18]; float* out; unsigned char* ws; int ph_lo, ph_hi; };
enum { I_X = 0, I_C, I_POS, I_WADA, I_BADA, I_WIN, I_GAQ, I_GAK, I_GBQ, I_GBK, I_GIK, I_WG, I_BG, I_WPA, I_WPB, I_WO, I_WUP, I_WDN };

__global__ void __launch_bounds__(NTHREADS, 2) mega(Args a) {
    extern __shared__ __attribute__((aligned(16))) unsigned char lds_raw[];
    LAS unsigned char* lds = (LAS unsigned char*)lds_raw;
    cg::grid_group grid = cg::this_grid();
    const int G = gridDim.x, NGW = G * NWAVES;
    unsigned char* ws = a.ws;
    float* mod = (float*)(ws + WS_MOD);
    bf16_t* H = (bf16_t*)(ws + WS_H); bf16_t* QKV = (bf16_t*)(ws + WS_QKV); float* IDXF = (float*)(ws + WS_IDXF); bf16_t* HID = (bf16_t*)(ws + WS_HID);
    bf16_t* IQ = (bf16_t*)(ws + WS_IQ); bf16_t* IK = (bf16_t*)(ws + WS_IK); float* IW = (float*)(ws + WS_IW); unsigned short* SEL = (unsigned short*)(ws + WS_SEL);
    bf16_t* OA = (bf16_t*)(ws + WS_OA); bf16_t* OB = (bf16_t*)(ws + WS_OB); bf16_t* GT = (bf16_t*)(ws + WS_G); bf16_t* MRG = (bf16_t*)(ws + WS_MRG); bf16_t* OG = (bf16_t*)(ws + WS_OG); float* LSE = (float*)(ws + WS_LSE); unsigned char* K8 = ws + WS_K8; unsigned char* V8 = ws + WS_V8; unsigned char* H8 = ws + WS_H8; float* RS = (float*)(ws + WS_RS); float* BVEC = (float*)(ws + WS_BVEC);

    { volatile LAS unsigned* st = (volatile LAS unsigned*)(lds + 131072 + 64);
      if (threadIdx.x < 2) st[threadIdx.x] = 0u;
      __syncthreads(); }
    const XcdBarrier xb = xcd_barrier_post((unsigned*)(ws + WS_BAR), (volatile LAS unsigned*)(lds + 131072 + 64));
    for (int ph = a.ph_lo; ph < a.ph_hi; ++ph) {
        int tid_ = threadIdx.x; asm volatile("" : "+v"(tid_)); const int tid = tid_, lane = tid & 63, wave = __builtin_amdgcn_readfirstlane(tid >> 6);
        const int gw = blockIdx.x * NWAVES + wave;
        if (ph == 0) { if (PHON(10)) { for (int rep = 0; rep < REP_PREP; ++rep) {
            for (int it = blockIdx.x; it < 2 * 384; it += G) mod_item(a.in[I_C], a.in[I_WADA], a.in[I_BADA], mod, (LAS float*)lds, it, tid);
            LAS float* scr = (LAS float*)(lds + wave * 16384);
            constexpr int I_IN8 = 32 * (QKVW / 32), I_I16 = 32 * (IDXW / 32), I_G8 = 32 * 128, I_PA = 8 * 64, I_PB = 16 * 64, I_O = 32 * 64, I_UP = 32 * 256, I_DN = 128 * 64;
            constexpr int PER_LAYER = I_IN8 + I_I16 + I_G8 + I_PA + I_PB + I_O + I_UP + I_DN;
            for (int it = gw; it < 2 * PER_LAYER; it += NGW) {
                const int l = it / PER_LAYER; int r = it % PER_LAYER; unsigned char* wl = ws + WS_W + (size_t)l * W_LAYER;
                const float* win = a.in[I_WIN] + (size_t)l * DM * NIN;
                if (r < I_IN8) { transpose_item<true>(win, NIN, DM, QKVW, QKVW, wl + W_IN8, scr, r, lane); continue; } r -= I_IN8;
                if (r < I_I16) { transpose_item<false>(win + QKVW, NIN, DM, NIN - QKVW, IDXW, wl + W_I16, scr, r, lane); continue; } r -= I_I16;
                if (r < I_G8) { transpose_item<true>(a.in[I_WG] + (size_t)l * DM * 4096, 4096, DM, 4096, 4096, wl + W_G8, scr, r, lane); continue; } r -= I_G8;
                if (r < I_PA) { transpose_item<false>(a.in[I_WPA] + (size_t)l * 512 * DM, DM, 512, DM, DM, wl + W_PA, scr, r, lane); continue; } r -= I_PA;
                if (r < I_PB) { transpose_item<false>(a.in[I_WPB] + (size_t)l * 1024 * DM, DM, 1024, DM, DM, wl + W_PB, scr, r, lane); continue; } r -= I_PB;
                if (r < I_O) { transpose_item<false>(a.in[I_WO] + (size_t)l * DM * DM, DM, DM, DM, DM, wl + W_O, scr, r, lane); continue; } r -= I_O;
                if (r < I_UP) { transpose_item<false>(a.in[I_WUP] + (size_t)l * DM * HIDN, HIDN, DM, HIDN, HIDN, wl + W_UP, scr, r, lane); continue; } r -= I_UP;
                transpose_item<false>(a.in[I_WDN] + (size_t)l * HIDN * DM, DM, HIDN, DM, DM, wl + W_DN, scr, r, lane);
            }
            __syncthreads(); } }
        } else {
            const int q = ph - 1, bl = q / 10, k = q % 10, b = bl >> 1, l = bl & 1;
            const unsigned char* wl = ws + WS_W + (size_t)l * W_LAYER;
            const float* md = mod + ((size_t)l * 2 + b) * NMOD;
            float* outb = a.out + (size_t)b * SEQ * DM;
            const float* xin = (l == 0) ? a.in[I_X] + (size_t)b * SEQ * DM : outb;
            if (k == 0) { if (PHON(0)) {
                for (int rep = 0; rep < REP_N; ++rep) for (int t = gw; t < SEQ; t += NGW) norm_row<true>(xin + (size_t)t * DM, md, md + DM, H + (size_t)t * DM, H8 + (size_t)t * DM, lane);
                for (int i = gw * 64 + lane; i < SEQ; i += NGW * 64) RS[i] = 0.f;
                { const bf16_t* WupT = (const bf16_t*)(wl + W_UP); const float* sh2 = md + 3 * DM;
                  for (int n = gw; n < HIDN; n += NGW) { const u32x4* wrow = (const u32x4*)(WupT + (size_t)n * DM); float s = 0.f;
#pragma unroll
                      for (int j = 0; j < 4; ++j) { const u32x4 w = wrow[lane + 64 * j]; const f32x4 h0 = *(const f32x4*)(sh2 + 8 * (lane + 64 * j)), h1 = *(const f32x4*)(sh2 + 8 * (lane + 64 * j) + 4);
                          s += (bf2f(w.x & 0xffffu) * h0[0] + __builtin_bit_cast(float, w.x & 0xffff0000u) * h0[1]) + (bf2f(w.y & 0xffffu) * h0[2] + __builtin_bit_cast(float, w.y & 0xffff0000u) * h0[3])
                             + (bf2f(w.z & 0xffffu) * h1[0] + __builtin_bit_cast(float, w.z & 0xffff0000u) * h1[1]) + (bf2f(w.w & 0xffffu) * h1[2] + __builtin_bit_cast(float, w.w & 0xffff0000u) * h1[3]); }
                      s = wave_sum(s); if (lane == 0) BVEC[n] = s; } }
            } } else if (k == 1) { if (PHON(1)) {
                for (int rep = 0; rep < REP_G; ++rep) {
                { Epi<0> E{QKV, nullptr, nullptr, nullptr, nullptr, 1.f / W8_SCALE}; run_gemm<0, true>(lds, H8, wl + W_IN8, QKVW, DM / 2, E); }
                { Epi<6> E{nullptr, IDXF, nullptr, nullptr, nullptr, 1.f}; run_gemm<6>(lds, H, wl + W_I16, IDXW, DM, E, (int)gridDim.x / 2); }
                { Epi<1> E{GT, nullptr, nullptr, a.in[I_BG] + (size_t)l * 4096, nullptr, 1.f / W8_SCALE}; run_gemm<1, true>(lds, H8, wl + W_G8, 4096, DM / 2, E); }
                }
            } } else if (k == 2) { if (PHON(2)) {
                const int* pos = (const int*)a.in[I_POS] + (size_t)b * SEQ;
                for (int rep = 0; rep < REP_POST; ++rep) for (int t = gw; t < SEQ; t += NGW)
                    post_token(pos[t], a.in[I_GAQ] + l * 128, a.in[I_GAK] + l * 128, a.in[I_GBQ] + l * 128, a.in[I_GBK] + l * 128, a.in[I_GIK] + l * 64,
                               QKV + (size_t)t * QKVW, IDXF + (size_t)t * IDXW, IQ + (size_t)t * 1024, IK + (size_t)t * 64, IW + (size_t)t * 16, K8 + (size_t)t * 1024, V8 + (size_t)t * 1024, lane);
            } } else if (k == 3) { if (PHON(3)) {
                for (int rep = 0; rep < REP_DIL; ++rep) for (int u = blockIdx.x; u < 1536; u += G) dilated_block(QKV, OG, LSE, lds, u, tid);
                __syncthreads();
                for (int rep = 0; rep < REP_IDX; ++rep) for (int pr = gw; pr < SEQ / NQI / 2; pr += NGW) {
                    indexer_unit(IQ, IK, IW, SEL, lds + wave * 16384, (SEQ / NQI - 1 - pr) * NQI, lane); indexer_unit(IQ, IK, IW, SEL, lds + wave * 16384, pr * NQI, lane); }
                __syncthreads();
            } } else if (k == 4) { if (PHON(4)) {
                const int h = blockIdx.x & 7, qg = (blockIdx.x >> 3) * NWAVES + wave, nqg = ((G + 7) >> 3) * NWAVES;
                for (int u = gw; u < SEQ * 4; u += NGW) dilated_merge(OG, LSE, OA, u >> 2, u & 3, lane);
                for (int rep = 0; rep < REP_SP; ++rep)
                if ((G & 7) == 0) { int seln[4];
#pragma unroll
                    for (int s = 0; s < 4; ++s) seln[s] = (int)SEL[(size_t)min(qg, SEQ - 1) * 256 + 64 * s + lane];
                    for (int t = qg; t < SEQ; t += nqg) { int selc[4];
#pragma unroll
                        for (int s = 0; s < 4; ++s) selc[s] = seln[s];
                        const int tn = min(t + nqg, SEQ - 1);
#pragma unroll
                        for (int s = 0; s < 4; ++s) seln[s] = (int)SEL[(size_t)tn * 256 + 64 * s + lane];
                        sparse_unit7(QKV, K8, V8, selc, OB, lds + wave * 4096, t, h, lane); } }
                else { for (int u = gw; u < SEQ * 8; u += NGW) { const int t = u >> 3; int selc[4];
#pragma unroll
                        for (int s = 0; s < 4; ++s) selc[s] = (int)SEL[(size_t)t * 256 + 64 * s + lane];
                        sparse_unit7(QKV, K8, V8, selc, OB, lds + wave * 4096, t, u & 7, lane); } }
            } } else if (k == 5) { if (PHON(5)) {
                for (int rep = 0; rep < REP_P; ++rep) {
                { Epi<2> E{MRG, nullptr, GT, nullptr, nullptr, 1.f}; run_gemm<2>(lds, OA, wl + W_PA, DM, 512, E); }
                { Epi<3> E{MRG, nullptr, GT, nullptr, nullptr, 1.f}; run_gemm<3>(lds, OB, wl + W_PB, DM, 1024, E); }
                }
            } } else if (k == 6) { if (PHON(6)) {
                Epi<7> E{H, outb, nullptr, md + 2 * DM, xin, 1.f, md + 4 * DM, RS}; run_gemm<7>(lds, MRG, wl + W_O, DM, DM, E);
            } } else if (k == 7) { if (PHON(7)) {
            } } else if (k == 8) { if (PHON(8)) {
                for (int rep = 0; rep < REP_G; ++rep) {                 Epi<8> E{HID, nullptr, nullptr, BVEC, nullptr, 1.f, nullptr, RS}; run_gemm<8>(lds, H, wl + W_UP, HIDN, DM, E); }
            } } else { if (PHON(9)) {
                Epi<4> E{nullptr, outb, nullptr, md + 5 * DM, outb, 1.f}; run_gemm<4>(lds, HID, wl + W_DN, DM, HIDN, E);
            } }
        }
        if (ph + 1 < a.ph_hi && !(ph > 0 && (ph - 1) % 10 == 7)) { if (ph == a.ph_lo) grid.sync(); else xcd_barrier(xb); }
    }
}

#ifndef MK_MULTI
#define MK_MULTI 0
#endif
extern "C" void kernel_launch(void* const* d_in, const int* in_sizes, int n_in, void* d_out, int out_size, void* d_ws, size_t ws_size, hipStream_t stream) {
    static int grid = 0;
    if (grid == 0) {
        if (n_in != 18 || out_size != NB * SEQ * DM || ws_size < WS_END) { fprintf(stderr, "kernel_launch: unexpected shapes (n_in %d out %d ws %zu)\n", n_in, out_size, ws_size); grid = -1; return; }
        int dev = 0, cus = 0, per_cu = 0;
        (void)hipGetDevice(&dev); (void)hipDeviceGetAttribute(&cus, hipDeviceAttributeMultiprocessorCount, dev);
        (void)hipFuncSetAttribute((const void*)mega, hipFuncAttributeMaxDynamicSharedMemorySize, LDS_BYTES);
        if (hipOccupancyMaxActiveBlocksPerMultiprocessor(&per_cu, (const void*)mega, NTHREADS, LDS_BYTES) != hipSuccess || per_cu < 1) per_cu = 1;
        (void)hipGetLastError();
        grid = cus * per_cu;
    }
    if (grid < 0) return;
    Args a{};
    for (int i = 0; i < 18; ++i) a.in[i] = (const float*)d_in[i];
    a.out = (float*)d_out; a.ws = (unsigned char*)d_ws;
#if MK_MULTI
    for (int ph = 0; ph < N_PHASES; ++ph) { a.ph_lo = ph; a.ph_hi = ph + 1; hipLaunchKernelGGL(mega, dim3(grid), dim3(NTHREADS), LDS_BYTES, stream, a); }
#else
    (void)hipMemsetAsync((unsigned char*)d_ws + WS_BAR, 0, BAR_BYTES, stream);
    a.ph_lo = 0; a.ph_hi = N_PHASES; void* args[] = {&a};
    hipError_t e = hipLaunchCooperativeKernel((const void*)mega, dim3(grid), dim3(NTHREADS), args, LDS_BYTES, stream);
    if (e != hipSuccess) fprintf(stderr, "cooperative launch failed: %s (grid %d)\n", hipGetErrorString(e), grid);
#endif
}
```

```cpp
#include <hip/hip_runtime.h>
#include <hip/hip_cooperative_groups.h>
#include <cstdio>
#include <cstdint>
namespace cg = cooperative_groups;
namespace pg8 {
#define PG8_LAS __attribute__((address_space(3)))
typedef unsigned short bf16_t;
typedef short bf16x8 __attribute__((ext_vector_type(8)));
typedef float f32x4 __attribute__((ext_vector_type(4)));
typedef unsigned u32x4 __attribute__((ext_vector_type(4)));
constexpr int BM = 256, BK = 64, HALF = 128, HTB = HALF * BK * 2  , STAGE_BYTES = 8 * HTB, NXCD = 8, WGM = 4;

__host__ __device__ __forceinline__ int lds_byte(int r, int c) { const int st = (r >> 4) * 2 + (c >> 5), rr = r & 15, cc = c & 31, ob = rr * 64 + cc * 2; return st * 1024 + (ob ^ (((ob >> 9) & 1) << 5)); }
__host__ __device__ __forceinline__ void stage_rc(int b, int& R, int& C) { const int st = b / 1024, sb = b % 1024, swz = sb ^ (((sb >> 9) & 1) << 5); R = (st >> 1) * 16 + swz / 64; C = (st & 1) * 32 + (swz % 64) / 2; }
__host__ __device__ __forceinline__ int perm32(int rho) { const int n = rho >> 4, i = rho & 15; return 8 * (i >> 2) + 4 * n + (i & 3); }

struct Unit { int pm, pn; };
struct Gemm { const bf16_t* A; const bf16_t* Bt; int M, N, K; };

struct StaticOrder {
    int nM, nN, nwg, G, c;
    __host__ __device__ void init(int M, int N, int G_, int c_) { nM = M / BM; nN = N / BM; nwg = nM * nN; G = G_; c = c_; }
    __host__ __device__ bool next(int i, Unit& u) const {
        const long L = (long)i * G + c; if (L >= nwg) return false;
        int wgid = (int)L; { const int q = nwg / NXCD, r = nwg % NXCD, xcd = wgid % NXCD, off = wgid / NXCD; wgid = (xcd < r ? xcd * (q + 1) : r * (q + 1) + (xcd - r) * q) + off; }
        const int nig = WGM * nN, gid = wgid / nig, fm = gid * WGM, gsz = (nM - fm) < WGM ? (nM - fm) : WGM;
        u.pm = fm + ((wgid % nig) % gsz); u.pn = (wgid % nig) / gsz; return true;
    }
    __device__ __forceinline__ void a_ready(const Unit&) const {}
    __device__ __forceinline__ void done(const Unit&) const {}
};

__device__ __forceinline__ unsigned cvt_pk_bf16(float lo, float hi) { unsigned r; asm volatile("v_cvt_pk_bf16_f32 %0, %1, %2" : "=v"(r) : "v"(lo), "v"(hi)); return r; }
template <class Epi, class Sched, bool ALIGN_EPI = false, bool SP2 = false, bool F8 = false>
__device__ __forceinline__ void gemm_phase(PG8_LAS unsigned char* lds, const Gemm g, const Sched& S, const Epi& E) {
    int tid_ = threadIdx.x; asm volatile("" : "+v"(tid_)); const int tid = tid_, wid = __builtin_amdgcn_readfirstlane(tid >> 6), lane = tid & 63, wr = wid >> 2, wc = wid & 3, fr = lane & 15, fq = lane >> 4;
    const int K = g.K, nt = K / BK;
    unsigned voffA[2], voffB[2];
#pragma unroll
    for (int i = 0; i < 2; ++i) { int R, C; stage_rc(tid * 16 + i * 8192, R, C); const int Rb = Epi::PERM ? ((R & ~31) + perm32(R & 31)) : R;
        voffA[i] = (unsigned)(R * K + C) * 2u; voffB[i] = (unsigned)(Rb * K + C) * 2u; }
    const size_t kstep = (size_t)(BK * 2);
    const size_t hstep = (size_t)HALF * K * 2;
    const size_t tstep = 2 * hstep;
    const unsigned ldsw = (unsigned)wid * 1024u;
    const int aoff = lds_byte(wr * 64 + fr, fq * 8), boff = lds_byte(wc * 32 + fr, fq * 8);
#define PG8_SA(b, h) (((b) * 2 + (h)) * HTB)
#define PG8_SB(b, h) ((4 + (b) * 2 + (h)) * HTB)
#define PG8_STAGE(bufoff, gbase, voff) do { _Pragma("unroll") for (int _i = 0; _i < 2; ++_i) \
        __builtin_amdgcn_global_load_lds((const unsigned*)((const char*)(gbase) + (voff)[_i]), (PG8_LAS unsigned*)(lds + (bufoff) + ldsw + _i * 8192), 16, 0, 0); } while (0)
#define PG8_CAT8(p0, p1) __builtin_shufflevector(*(const PG8_LAS i4_t*)(p0), *(const PG8_LAS i4_t*)(p1), 0, 1, 2, 3, 4, 5, 6, 7)
#define PG8_LDA(dst, b, h) do { if constexpr (F8) { _Pragma("unroll") for (int m = 0; m < 4; ++m) dst##8[m] = PG8_CAT8(lds + PG8_SA(b, h) + aoff + m * 2048, lds + PG8_SA(b, h) + aoff + m * 2048 + 1024); } \
        else { _Pragma("unroll") for (int m = 0; m < 4; ++m) _Pragma("unroll") for (int k = 0; k < 2; ++k) dst[m][k] = *(const PG8_LAS bf16x8*)(lds + PG8_SA(b, h) + aoff + m * 2048 + k * 1024); } } while (0)
#define PG8_LDB(dst, b, h) do { if constexpr (F8) { _Pragma("unroll") for (int n = 0; n < 2; ++n) dst##8[n] = PG8_CAT8(lds + PG8_SB(b, h) + boff + n * 2048, lds + PG8_SB(b, h) + boff + n * 2048 + 1024); } \
        else { _Pragma("unroll") for (int n = 0; n < 2; ++n) _Pragma("unroll") for (int k = 0; k < 2; ++k) dst[n][k] = *(const PG8_LAS bf16x8*)(lds + PG8_SB(b, h) + boff + n * 2048 + k * 1024); } } while (0)
#define PG8_MMA(ai, bj, At, Bt) do { __builtin_amdgcn_s_setprio(1); \
        if constexpr (F8) { _Pragma("unroll") for (int m = 0; m < 4; ++m) _Pragma("unroll") for (int n = 0; n < 2; ++n) \
                asm volatile("v_mfma_scale_f32_16x16x128_f8f6f4 %0, %1, %2, %0, %3, %3 op_sel_hi:[0,0,0]" : "+v"(acc[ai][bj][m][n]) : "v"(Bt##8[n]), "v"(At##8[m]), "v"(f8scale)); } \
        else { _Pragma("unroll") for (int m = 0; m < 4; ++m) _Pragma("unroll") for (int n = 0; n < 2; ++n) _Pragma("unroll") for (int k = 0; k < 2; ++k) \
                acc[ai][bj][m][n] = __builtin_amdgcn_mfma_f32_16x16x32_bf16(Bt[n][k], At[m][k], acc[ai][bj][m][n], 0, 0, 0); } \
        __builtin_amdgcn_s_setprio(0); } while (0)
#define PG8_WAIT_V(n) asm volatile("s_waitcnt vmcnt(" #n ")" ::: "memory")
#define PG8_WAIT_L(n) asm volatile("s_waitcnt lgkmcnt(" #n ")" ::: "memory")
#define PG8_BAR __builtin_amdgcn_s_barrier()
#define PG8_SCHED __builtin_amdgcn_sched_barrier(0)
    Unit cur, nxt; int ui = 0;
    if (!S.next(0, cur)) return;
    f32x4 acc[2][2][4][2];
#pragma unroll
    for (int a = 0; a < 2; ++a)
#pragma unroll
        for (int b = 0; b < 2; ++b)
#pragma unroll
            for (int m = 0; m < 4; ++m)
#pragma unroll
                for (int n = 0; n < 2; ++n) acc[a][b][m][n] = (f32x4){0.f, 0.f, 0.f, 0.f};
    typedef int i8_t __attribute__((ext_vector_type(8))); typedef int i4_t __attribute__((ext_vector_type(4)));
    bf16x8 At[4][2], B0[2][2], B1[2][2]; i8_t At8[4], B08[2], B18[2];
    int f8scale = 0x7f7f7f7f; asm volatile("" : "+v"(f8scale));
    const char* cA = (const char*)g.A + (size_t)cur.pm * tstep; const char* cB = (const char*)g.Bt + (size_t)cur.pn * tstep;
    S.a_ready(cur);
    if constexpr (SP2) {
        PG8_STAGE(PG8_SB(0, 0), cB, voffB); PG8_STAGE(PG8_SB(0, 1), cB + hstep, voffB); PG8_STAGE(PG8_SA(0, 0), cA, voffA); PG8_STAGE(PG8_SA(0, 1), cA + hstep, voffA);
        if (wr == 1) PG8_BAR;
        PG8_WAIT_V(2); PG8_BAR;
        PG8_STAGE(PG8_SB(1, 0), cB + kstep, voffB); PG8_STAGE(PG8_SA(1, 0), cA + kstep, voffA); PG8_STAGE(PG8_SB(1, 1), cB + hstep + kstep, voffB);
        PG8_WAIT_V(6); PG8_BAR;
    } else {
        PG8_STAGE(PG8_SB(0, 0), cB, voffB); PG8_STAGE(PG8_SA(0, 0), cA, voffA); PG8_STAGE(PG8_SB(0, 1), cB + hstep, voffB); PG8_STAGE(PG8_SA(0, 1), cA + hstep, voffA);
        if (wr == 1) PG8_BAR;
        PG8_WAIT_V(4); PG8_BAR;
        PG8_STAGE(PG8_SB(1, 0), cB + kstep, voffB); PG8_STAGE(PG8_SA(1, 0), cA + kstep, voffA); PG8_STAGE(PG8_SB(1, 1), cB + hstep + kstep, voffB);
        PG8_WAIT_V(6); PG8_BAR;
    }
    for (;;) {
        const bool has_next = S.next(ui + 1, nxt);
        const char* nA = has_next ? (const char*)g.A + (size_t)nxt.pm * tstep : cA; const char* nB = has_next ? (const char*)g.Bt + (size_t)nxt.pn * tstep : cB;
        for (int t = 0; t < nt; t += 2) {
            const bool last = (t == nt - 2);
            const char* a1 = cA + (size_t)(t + 1) * kstep;
            const char* a2 = last ? nA : cA + (size_t)(t + 2) * kstep; const char* b2 = last ? nB : cB + (size_t)(t + 2) * kstep;
            const char* a3 = a2 + kstep; const char* b3 = b2 + kstep;
            if (last && has_next) S.a_ready(nxt);
            if constexpr (SP2) {
            PG8_LDB(B0, 0, 0); PG8_LDB(B1, 0, 1); PG8_SCHED; PG8_LDA(At, 0, 0); PG8_STAGE(PG8_SA(1, 1), a1 + hstep, voffA);
            PG8_WAIT_V(8); PG8_WAIT_L(0); PG8_BAR; PG8_MMA(0, 0, At, B0); PG8_MMA(0, 1, At, B1); PG8_BAR; PG8_SCHED;
            PG8_LDA(At, 0, 1); PG8_STAGE(PG8_SB(0, 0), b2, voffB); PG8_STAGE(PG8_SB(0, 1), b2 + hstep, voffB); PG8_STAGE(PG8_SA(0, 0), a2, voffA);
            PG8_WAIT_V(8); PG8_WAIT_L(0); PG8_BAR; PG8_MMA(1, 0, At, B0); PG8_MMA(1, 1, At, B1); PG8_BAR; PG8_SCHED;
            PG8_LDB(B0, 1, 0); PG8_LDB(B1, 1, 1); PG8_SCHED; PG8_LDA(At, 1, 0); PG8_STAGE(PG8_SA(0, 1), a2 + hstep, voffA);
            PG8_WAIT_V(8); PG8_WAIT_L(0); PG8_BAR; PG8_MMA(0, 0, At, B0); PG8_MMA(0, 1, At, B1); PG8_BAR; PG8_SCHED;
            PG8_LDA(At, 1, 1); PG8_STAGE(PG8_SB(1, 0), b3, voffB); PG8_STAGE(PG8_SB(1, 1), b3 + hstep, voffB); PG8_STAGE(PG8_SA(1, 0), a3, voffA);
            PG8_WAIT_V(8); PG8_WAIT_L(0); PG8_BAR; PG8_MMA(1, 0, At, B0); PG8_MMA(1, 1, At, B1); PG8_BAR; PG8_SCHED;
            } else {
            PG8_LDB(B0, 0, 0); PG8_SCHED; PG8_LDA(At, 0, 0); PG8_STAGE(PG8_SA(1, 1), a1 + hstep, voffA);
            PG8_WAIT_L(8); PG8_BAR; PG8_WAIT_L(0); PG8_MMA(0, 0, At, B0); PG8_BAR; PG8_SCHED;
            PG8_LDB(B1, 0, 1); PG8_STAGE(PG8_SB(0, 0), b2, voffB);
            PG8_BAR; PG8_WAIT_L(0); PG8_MMA(0, 1, At, B1); PG8_BAR;
            PG8_LDA(At, 0, 1); PG8_STAGE(PG8_SA(0, 0), a2, voffA);
            PG8_BAR; PG8_WAIT_L(0); PG8_MMA(1, 0, At, B0); PG8_BAR; PG8_SCHED;
            PG8_STAGE(PG8_SB(0, 1), b2 + hstep, voffB);
            PG8_WAIT_V(6); PG8_BAR; PG8_MMA(1, 1, At, B1); PG8_BAR;
            PG8_LDB(B0, 1, 0); PG8_SCHED; PG8_LDA(At, 1, 0); PG8_STAGE(PG8_SA(0, 1), a2 + hstep, voffA);
            PG8_WAIT_L(8); PG8_BAR; PG8_WAIT_L(0); PG8_MMA(0, 0, At, B0); PG8_BAR; PG8_SCHED;
            PG8_LDB(B1, 1, 1); PG8_STAGE(PG8_SB(1, 0), b3, voffB);
            PG8_BAR; PG8_WAIT_L(0); PG8_MMA(0, 1, At, B1); PG8_BAR;
            PG8_LDA(At, 1, 1); PG8_STAGE(PG8_SA(1, 0), a3, voffA);
            PG8_BAR; PG8_WAIT_L(0); PG8_MMA(1, 0, At, B0); PG8_BAR; PG8_SCHED;
            PG8_STAGE(PG8_SB(1, 1), b3 + hstep, voffB);
            PG8_WAIT_V(6); PG8_BAR; PG8_MMA(1, 1, At, B1); PG8_BAR;
            }
        }
        if constexpr (ALIGN_EPI) { if (wr == 0) PG8_BAR; }
        if constexpr (F8) asm volatile("s_nop 15\n\ts_nop 15" : "+v"(acc[1][1][0][0]), "+v"(acc[1][1][0][1]), "+v"(acc[1][1][1][0]), "+v"(acc[1][1][1][1]), "+v"(acc[1][1][2][0]), "+v"(acc[1][1][2][1]), "+v"(acc[1][1][3][0]), "+v"(acc[1][1][3][1]));
        if constexpr (!Epi::AFTER_DRAIN) { E(acc, cur, wr, wc, fr, fq); S.done(cur); }
        if (!has_next) break;
#pragma unroll
        for (int a = 0; a < 2; ++a)
#pragma unroll
            for (int b = 0; b < 2; ++b)
#pragma unroll
                for (int m = 0; m < 4; ++m)
#pragma unroll
                    for (int n = 0; n < 2; ++n) acc[a][b][m][n] = (f32x4){0.f, 0.f, 0.f, 0.f};
        cur = nxt; cA = nA; cB = nB; ++ui;
        if constexpr (ALIGN_EPI) { if (wr == 1) PG8_BAR; }
    }
    PG8_WAIT_V(0);
    if constexpr (!ALIGN_EPI) { if (wr == 0) PG8_BAR; }
    PG8_BAR;
    if constexpr (Epi::AFTER_DRAIN) { E.fused(acc, cur, wr, wc, fr, fq, lds, wid, lane); S.done(cur); }
#undef PG8_SA
#undef PG8_SB
#undef PG8_STAGE
#undef PG8_LDA
#undef PG8_CAT8
#undef PG8_LDB
#undef PG8_MMA
#undef PG8_WAIT_V
#undef PG8_WAIT_L
#undef PG8_BAR
#undef PG8_SCHED
}
}

using pg8::bf16_t; using pg8::bf16x8; using pg8::f32x4; using pg8::u32x4;
typedef unsigned u32x2 __attribute__((ext_vector_type(2)));
#define LAS __attribute__((address_space(3)))
constexpr int DM = 2048, NB = 2, SEQ = 16384, DEPTH = 2;
constexpr int NIN = 8784, NINP = 8960, QKVW = 7680, IDXW = 1280, HIDN = 8192, NMOD = 12288;
constexpr int COL_AQ = 0, COL_AK = 1536, COL_AV = 3072, COL_BQ = 4608, COL_BK = 5632, COL_BV = 6656;
constexpr float EPS = 1e-6f;
constexpr int NWAVES = 8, NTHREADS = 512;
constexpr int LDS_BYTES = 147456;
constexpr size_t MiB = 1u << 20;
constexpr size_t WS_MOD = 0, WS_RS = 256 * 1024  , WS_BVEC = 320 * 1024  , WS_BAR = 512 * 1024, BAR_BYTES = 16384, WS_W = 1 * MiB;
constexpr size_t W_I16 = 0, W_IN8 = 5 * MiB, W_G8 = 20 * MiB, W_PA = 35 * MiB, W_PB = 37 * MiB, W_O = 41 * MiB, W_UP = 49 * MiB, W_DN = 81 * MiB, W_LAYER = 113 * MiB;
constexpr float W8_SCALE = 64.f;
constexpr size_t WS_H = WS_W + 2 * W_LAYER;
constexpr size_t WS_QKV = WS_H + 64 * MiB;
constexpr size_t WS_IDXF = WS_QKV + 240 * MiB;
constexpr size_t WS_HID = WS_QKV;
constexpr size_t WS_IQ = WS_IDXF + 80 * MiB;
constexpr size_t WS_IK = WS_IQ + 32 * MiB;
constexpr size_t WS_IW = WS_IK + 2 * MiB;
constexpr size_t WS_SEL = WS_IW + 1 * MiB;
constexpr size_t WS_OA = WS_SEL + 8 * MiB;
constexpr size_t WS_OB = WS_OA + 16 * MiB;
constexpr size_t WS_G = WS_OB + 32 * MiB;
constexpr size_t WS_MRG = WS_G + 128 * MiB;
constexpr size_t WS_OG = WS_MRG + 64 * MiB;
constexpr size_t WS_LSE = WS_OG + 48 * MiB;
constexpr size_t WS_K8 = WS_LSE + 1 * MiB;
constexpr size_t WS_V8 = WS_K8 + 16 * MiB;
constexpr size_t WS_H8 = WS_V8 + 16 * MiB;
constexpr size_t WS_END = WS_H8 + 32 * MiB;
static_assert(WS_END <= (size_t)1024 * MiB, "workspace map");
constexpr int N_PHASES = 1 + NB * DEPTH * 10;

__device__ const float INVF[64] = {1.0f,0.865964353f,0.749894261f,0.649381638f,0.562341332f,0.486967534f,0.421696514f,0.365174115f,0.316227764f,0.273841977f,0.237137377f,0.2053525f,0.177827939f,0.153992653f,0.133352131f,0.115478203f,0.100000001f,0.0865964293f,0.0749894157f,0.0649381652f,0.0562341325f,0.0486967526f,0.0421696529f,0.0365174115f,0.0316227749f,0.0273841973f,0.0237137377f,0.0205352511f,0.0177827943f,0.0153992651f,0.0133352149f,0.0115478206f,0.00999999978f,0.00865964312f,0.00749894185f,0.00649381615f,0.00562341325f,0.00486967526f,0.00421696482f,0.00365174119f,0.00316227763f,0.00273841969f,0.00237137359f,0.00205352483f,0.00177827943f,0.00153992651f,0.00133352145f,0.0011547819f,0.00100000005f,0.000865964335f,0.000749894243f,0.000649381662f,0.000562341302f,0.000486967532f,0.000421696517f,0.000365174143f,0.000316227757f,0.000273841957f,0.00023713737f,0.00020535251f,0.00017782794f,0.000153992645f,0.00013335215f,0.0001154782f};

__device__ __forceinline__ float bf2f(unsigned u16) { return __builtin_bit_cast(float, u16 << 16); }
__device__ __forceinline__ unsigned f2bf(float f) { unsigned u = __builtin_bit_cast(unsigned, f); return (u + 0x7fffu + ((u >> 16) & 1u)) >> 16; }
__device__ __forceinline__ unsigned pk2(float lo, float hi) { return f2bf(lo) | (f2bf(hi) << 16); }
template <int CTRL> __device__ __forceinline__ float dpp_f(float v) { return __builtin_bit_cast(float, __builtin_amdgcn_update_dpp(0, __builtin_bit_cast(int, v), CTRL, 0xF, 0xF, true)); }
template <int CTRL> __device__ __forceinline__ int dpp_i(int v) { return __builtin_amdgcn_update_dpp(0, v, CTRL, 0xF, 0xF, true); }
__device__ __forceinline__ void pl32(unsigned a, unsigned b, unsigned& ra, unsigned& rb) { asm volatile("" : "+v"(b)); auto r = __builtin_amdgcn_permlane32_swap(a, b, false, false); ra = r[0]; rb = r[1]; asm volatile("" : "+v"(ra), "+v"(rb)); }
__device__ __forceinline__ void pl16(unsigned a, unsigned b, unsigned& ra, unsigned& rb) { asm volatile("" : "+v"(b)); auto r = __builtin_amdgcn_permlane16_swap(a, b, false, false); ra = r[0]; rb = r[1]; asm volatile("" : "+v"(ra), "+v"(rb)); }
__device__ __forceinline__ float swap32_sum(float a, float b) { unsigned x, y; pl32(__builtin_bit_cast(unsigned, a), __builtin_bit_cast(unsigned, b), x, y); return __builtin_bit_cast(float, x) + __builtin_bit_cast(float, y); }
__device__ __forceinline__ float swap16_sum(float a, float b) { unsigned x, y; pl16(__builtin_bit_cast(unsigned, a), __builtin_bit_cast(unsigned, b), x, y); return __builtin_bit_cast(float, x) + __builtin_bit_cast(float, y); }
__device__ __forceinline__ float wave_sum(float v) {
    v += dpp_f<0x128>(v); v += dpp_f<0x124>(v); v += dpp_f<0x4E>(v); v += dpp_f<0xB1>(v);
    v = swap16_sum(v, v); return swap32_sum(v, v);
}
__device__ __forceinline__ float wave_max(float v) {
    v = fmaxf(v, dpp_f<0x128>(v)); v = fmaxf(v, dpp_f<0x124>(v)); v = fmaxf(v, dpp_f<0x4E>(v)); v = fmaxf(v, dpp_f<0xB1>(v));
    unsigned x, y;
    pl16(__builtin_bit_cast(unsigned, v), __builtin_bit_cast(unsigned, v), x, y); v = fmaxf(__builtin_bit_cast(float, x), __builtin_bit_cast(float, y));
    pl32(__builtin_bit_cast(unsigned, v), __builtin_bit_cast(unsigned, v), x, y); v = fmaxf(__builtin_bit_cast(float, x), __builtin_bit_cast(float, y));
    return v;
}
__device__ __forceinline__ int wave_sum_i(int v) {
    v += dpp_i<0x128>(v); v += dpp_i<0x124>(v); v += dpp_i<0x4E>(v); v += dpp_i<0xB1>(v);
    unsigned x, y;
    pl16((unsigned)v, (unsigned)v, x, y); v = (int)(x + y);
    pl32((unsigned)v, (unsigned)v, x, y); v = (int)(x + y);
    return v;
}
__device__ __forceinline__ int lane_prefix(unsigned long long mask) { return __builtin_amdgcn_mbcnt_hi((unsigned)(mask >> 32), __builtin_amdgcn_mbcnt_lo((unsigned)mask, 0)); }
__device__ __forceinline__ void rope_cs(float ang, float& c, float& s) {
    double rev = (double)ang * 0.15915494309189535; rev -= __builtin_rint(rev); const float rf = (float)rev;
    s = __builtin_amdgcn_sinf(rf); c = __builtin_amdgcn_cosf(rf);
}

__device__ __forceinline__ u32x2 to_fp8x8(const float (&o)[8]) {
    u32x2 w; int t0 = __builtin_amdgcn_cvt_pk_fp8_f32(o[0], o[1], 0, false); t0 = __builtin_amdgcn_cvt_pk_fp8_f32(o[2], o[3], t0, true);
    int t1 = __builtin_amdgcn_cvt_pk_fp8_f32(o[4], o[5], 0, false); t1 = __builtin_amdgcn_cvt_pk_fp8_f32(o[6], o[7], t1, true); w.x = (unsigned)t0; w.y = (unsigned)t1; return w;
}

template <int MODE> struct Epi {
    static constexpr bool PERM = true, AFTER_DRAIN = false;
    bf16_t* ob; float* of; const bf16_t* aux; const float* vec; const float* xsrc; float scale; const float* vec2; float* rs;
    __device__ __forceinline__ void operator()(const f32x4 (&acc)[2][2][4][2], const pg8::Unit& u, int wr, int wc, int fr, int fq) const {
        const int row0 = u.pm * 256 + wr * 64 + fr, col0 = u.pn * 256 + wc * 32 + 8 * fq;
#pragma unroll
        for (int ai = 0; ai < 2; ++ai)
#pragma unroll
            for (int m = 0; m < 4; ++m) {
                const size_t row = (size_t)(row0 + ai * 128 + m * 16);
                float ssq = 0.f, rstd = 1.f;
                if constexpr (MODE == 8) rstd = 1.f / sqrtf(rs[row] * (1.f / DM) + EPS);
#pragma unroll
                for (int bj = 0; bj < 2; ++bj) {
                    const int col = col0 + bj * 128;
                    f32x4 v0 = acc[ai][bj][m][0], v1 = acc[ai][bj][m][1];
                    if constexpr (MODE == 0 || MODE == 1) { v0 = v0 * scale; v1 = v1 * scale; }
                    if constexpr (MODE == 6) { float* p = of + row * IDXW + col; *(f32x4*)p = v0; *(f32x4*)(p + 4) = v1; }
                    else if constexpr (MODE == 0) {
                        if (u.pn >= COL_BV / 256) {
                            const float x8[8] = {v0[0], v0[1], v0[2], v0[3], v1[0], v1[1], v1[2], v1[3]};
                            *(u32x2*)((unsigned char*)aux + row * 1024 + (col - COL_BV)) = to_fp8x8(x8);
                        } else { u32x4 w; w.x = pk2(v0[0], v0[1]); w.y = pk2(v0[2], v0[3]); w.z = pk2(v1[0], v1[1]); w.w = pk2(v1[2], v1[3]);
                            *(u32x4*)(ob + row * QKVW + col) = w; }
                    } else if constexpr (MODE == 1) {
                        const f32x4 b0 = *(const f32x4*)(vec + col), b1 = *(const f32x4*)(vec + col + 4);
                        float r[8];
#pragma unroll
                        for (int i = 0; i < 4; ++i) { r[i] = 1.f / (1.f + __expf(-(v0[i] + b0[i]))); r[4 + i] = 1.f / (1.f + __expf(-(v1[i] + b1[i]))); }
                        u32x4 w; w.x = pk2(r[0], r[1]); w.y = pk2(r[2], r[3]); w.z = pk2(r[4], r[5]); w.w = pk2(r[6], r[7]);
                        *(u32x4*)(ob + row * 4096 + col) = w;
                    } else if constexpr (MODE == 2 || MODE == 3) {
                        const u32x4 g = *(const u32x4*)(aux + row * 4096 + (MODE == 3 ? 2048 : 0) + col);
                        float r[8] = {v0[0], v0[1], v0[2], v0[3], v1[0], v1[1], v1[2], v1[3]};
                        const unsigned gw[4] = {g.x, g.y, g.z, g.w};
#pragma unroll
                        for (int i = 0; i < 4; ++i) { r[2 * i] *= bf2f(gw[i] & 0xffffu); r[2 * i + 1] *= __builtin_bit_cast(float, gw[i] & 0xffff0000u); }
                        if constexpr (MODE == 3) { const u32x4 pv = *(const u32x4*)(ob + row * 2048 + col); const unsigned pw[4] = {pv.x, pv.y, pv.z, pv.w};
#pragma unroll
                            for (int i = 0; i < 4; ++i) { r[2 * i] += bf2f(pw[i] & 0xffffu); r[2 * i + 1] += __builtin_bit_cast(float, pw[i] & 0xffff0000u); } }
                        u32x4 w; w.x = pk2(r[0], r[1]); w.y = pk2(r[2], r[3]); w.z = pk2(r[4], r[5]); w.w = pk2(r[6], r[7]);
                        *(u32x4*)(ob + row * 2048 + col) = w;
                    } else if constexpr (MODE == 4) {
                        const f32x4 g0 = *(const f32x4*)(vec + col), g1 = *(const f32x4*)(vec + col + 4);
                        const f32x4 x0 = *(const f32x4*)(xsrc + row * DM + col), x1 = *(const f32x4*)(xsrc + row * DM + col + 4);
                        *(f32x4*)(of + row * DM + col) = x0 + g0 * v0; *(f32x4*)(of + row * DM + col + 4) = x1 + g1 * v1;
                    } else if constexpr (MODE == 7) {
                        const f32x4 g0 = *(const f32x4*)(vec + col), g1 = *(const f32x4*)(vec + col + 4);
                        const f32x4 x0 = *(const f32x4*)(xsrc + row * DM + col), x1 = *(const f32x4*)(xsrc + row * DM + col + 4);
                        const f32x4 y0 = x0 + g0 * v0, y1 = x1 + g1 * v1;
                        *(f32x4*)(of + row * DM + col) = y0; *(f32x4*)(of + row * DM + col + 4) = y1;
                        ssq += (y0[0] * y0[0] + y0[1] * y0[1]) + (y0[2] * y0[2] + y0[3] * y0[3]) + (y1[0] * y1[0] + y1[1] * y1[1]) + (y1[2] * y1[2] + y1[3] * y1[3]);
                        const f32x4 s0 = *(const f32x4*)(vec2 + col) + 1.f, s1 = *(const f32x4*)(vec2 + col + 4) + 1.f;
                        const f32x4 a0 = y0 * s0, a1 = y1 * s1;
                        u32x4 w; w.x = pk2(a0[0], a0[1]); w.y = pk2(a0[2], a0[3]); w.z = pk2(a1[0], a1[1]); w.w = pk2(a1[2], a1[3]);
                        *(u32x4*)(ob + row * DM + col) = w;
                    } else if constexpr (MODE == 8) {
                        const f32x4 b0 = *(const f32x4*)(vec + col), b1 = *(const f32x4*)(vec + col + 4);
                        float r[8] = {v0[0] * rstd + b0[0], v0[1] * rstd + b0[1], v0[2] * rstd + b0[2], v0[3] * rstd + b0[3], v1[0] * rstd + b1[0], v1[1] * rstd + b1[1], v1[2] * rstd + b1[2], v1[3] * rstd + b1[3]};
#pragma unroll
                        for (int i = 0; i < 8; ++i) { const float q = fmaxf(r[i], 0.f); r[i] = q * q; }
                        u32x4 w; w.x = pk2(r[0], r[1]); w.y = pk2(r[2], r[3]); w.z = pk2(r[4], r[5]); w.w = pk2(r[6], r[7]);
                        *(u32x4*)(ob + row * HIDN + col) = w;
                    } else {
                        float r[8] = {v0[0], v0[1], v0[2], v0[3], v1[0], v1[1], v1[2], v1[3]};
#pragma unroll
                        for (int i = 0; i < 8; ++i) { const float q = fmaxf(r[i], 0.f); r[i] = q * q; }
                        u32x4 w; w.x = pk2(r[0], r[1]); w.y = pk2(r[2], r[3]); w.z = pk2(r[4], r[5]); w.w = pk2(r[6], r[7]);
                        *(u32x4*)(ob + row * HIDN + col) = w;
                    }
                }
                if constexpr (MODE == 7) {
                    ssq = swap16_sum(ssq, ssq); ssq = swap32_sum(ssq, ssq);
                    if (fq == 0) (void)__hip_atomic_fetch_add(rs + row, ssq, __ATOMIC_RELAXED, __HIP_MEMORY_SCOPE_AGENT);
                }
            }
    }
};

template <int MODE, bool F8 = false>
__device__ __forceinline__ void run_gemm(LAS unsigned char* lds, const void* A, const void* Bt, int N, int K, const Epi<MODE>& E, int rot = 0) {
    pg8::Gemm g{(const bf16_t*)A, (const bf16_t*)Bt, SEQ, N, K}; pg8::StaticOrder S; S.init(SEQ, N, (int)gridDim.x, (int)((blockIdx.x + rot) % gridDim.x));
    pg8::gemm_phase<Epi<MODE>, pg8::StaticOrder, true, true, F8>(lds, g, S, E);
}

template <bool F8>
__device__ __forceinline__ void transpose_item(const float* W, int ldw, int K, int N, int Npad, void* WTv, LAS float* scr, int item, int lane) {
    const int nblk = Npad / 32, kb = item / nblk, nb = item % nblk, k0 = 64 * kb, n0 = 32 * nb;
    const int c4 = (lane & 7) * 4; const bool ok = (n0 + c4) < N;
    f32x4 tv[8];
#pragma unroll
    for (int i = 0; i < 8; ++i) { const int kk = 8 * i + (lane >> 3); tv[i] = ok ? *(const f32x4*)(W + (size_t)(k0 + kk) * ldw + n0 + c4) : (f32x4){0.f, 0.f, 0.f, 0.f}; }
#pragma unroll
    for (int i = 0; i < 8; ++i) { const int kk = 8 * i + (lane >> 3); LAS float* d = scr + kk * 33 + c4; d[0] = tv[i][0]; d[1] = tv[i][1]; d[2] = tv[i][2]; d[3] = tv[i][3]; }
    asm volatile("s_waitcnt lgkmcnt(0)" ::: "memory");
    const int c = lane & 7;
#pragma unroll
    for (int j = 0; j < 4; ++j) { const int n = (lane >> 3) + 8 * j; const LAS float* s = scr + (8 * c) * 33 + n;
        if constexpr (F8) { const float x[8] = {s[0] * W8_SCALE, s[33] * W8_SCALE, s[66] * W8_SCALE, s[99] * W8_SCALE, s[132] * W8_SCALE, s[165] * W8_SCALE, s[198] * W8_SCALE, s[231] * W8_SCALE};
            *(u32x2*)((unsigned char*)WTv + (size_t)(n0 + n) * K + k0 + 8 * c) = to_fp8x8(x); }
        else { u32x4 o; o.x = pk2(s[0 * 33], s[1 * 33]); o.y = pk2(s[2 * 33], s[3 * 33]); o.z = pk2(s[4 * 33], s[5 * 33]); o.w = pk2(s[6 * 33], s[7 * 33]);
            *(u32x4*)((bf16_t*)WTv + (size_t)(n0 + n) * K + k0 + 8 * c) = o; } }
    asm volatile("s_waitcnt lgkmcnt(0)" ::: "memory");
}

__device__ __forceinline__ void mod_item(const float* c, const float* w_ada, const float* b_ada, float* mod, LAS float* red, int it, int tid) {
    const int l = it / 384, n0 = (it % 384) * 32, cl = tid & 7, kg = tid >> 3;
    const float* W = w_ada + (size_t)l * DM * NMOD + n0 + 4 * cl;
    f32x4 a0 = {0.f, 0.f, 0.f, 0.f}, a1 = {0.f, 0.f, 0.f, 0.f};
#pragma unroll 16
    for (int k = kg * 32; k < kg * 32 + 32; ++k) {
        const f32x4 w = *(const f32x4*)(W + (size_t)k * NMOD); float c0 = c[k], c1 = c[DM + k];
        c0 = c0 / (1.f + __expf(-c0)); c1 = c1 / (1.f + __expf(-c1)); a0 += w * c0; a1 += w * c1; }
#pragma unroll
    for (int e = 0; e < 4; ++e) { red[(kg * 2 + 0) * 32 + 4 * cl + e] = a0[e]; red[(kg * 2 + 1) * 32 + 4 * cl + e] = a1[e]; }
    __syncthreads();
    if (tid < 64) { const int b = tid >> 5, col = tid & 31; float s = 0.f;
#pragma unroll 16
        for (int g = 0; g < 64; ++g) s += red[(g * 2 + b) * 32 + col];
        mod[((size_t)l * 2 + b) * NMOD + n0 + col] = s + b_ada[(size_t)l * NMOD + n0 + col]; }
    __syncthreads();
}

template <bool F8>
__device__ __forceinline__ void norm_row(const float* xrow, const float* sh, const float* sc, bf16_t* hrow, unsigned char* h8row, int lane) {
    f32x4 v[8]; float ss = 0.f;
#pragma unroll
    for (int j = 0; j < 8; ++j) { v[j] = ((const f32x4*)xrow)[lane + 64 * j]; ss += (v[j].x * v[j].x + v[j].y * v[j].y) + (v[j].z * v[j].z + v[j].w * v[j].w); }
    ss = wave_sum(ss); const float r = 1.f / sqrtf(ss * (1.f / DM) + EPS);
#pragma unroll
    for (int j = 0; j < 8; ++j) { const f32x4 s4 = ((const f32x4*)sc)[lane + 64 * j], h4 = ((const f32x4*)sh)[lane + 64 * j];
        const f32x4 y = v[j] * r * (s4 + 1.f) + h4; u32x2 o; o.x = pk2(y.x, y.y); o.y = pk2(y.z, y.w); ((u32x2*)hrow)[lane + 64 * j] = o;
        if constexpr (F8) { int t0 = __builtin_amdgcn_cvt_pk_fp8_f32(y.x, y.y, 0, false); t0 = __builtin_amdgcn_cvt_pk_fp8_f32(y.z, y.w, t0, true); ((unsigned*)h8row)[lane + 64 * j] = (unsigned)t0; } }
}

__device__ __forceinline__ float row16_sum(float v) { v += dpp_f<0x128>(v); v += dpp_f<0x124>(v); v += dpp_f<0x4E>(v); v += dpp_f<0xB1>(v); return v; }
template <int NIT, bool F8>
__device__ __forceinline__ void post_segment(bf16_t* seg, const float* gain, const float (&cs)[8], const float (&sn)[8], int c, int grp, unsigned char* k8 = nullptr) {
    const f32x4 g0 = *(const f32x4*)(gain + 8 * c), g1 = *(const f32x4*)(gain + 8 * c + 4);
    const float g[8] = {g0[0], g0[1], g0[2], g0[3], g1[0], g1[1], g1[2], g1[3]};
    u32x4 raw[NIT];
#pragma unroll
    for (int it = 0; it < NIT; ++it) raw[it] = *(const u32x4*)(seg + (it * 4 + grp) * 128 + c * 8);
#pragma unroll
    for (int it = 0; it < NIT; ++it) {
        const unsigned w[4] = {raw[it].x, raw[it].y, raw[it].z, raw[it].w}; float x[8];
#pragma unroll
        for (int i = 0; i < 4; ++i) { x[2 * i] = bf2f(w[i] & 0xffffu); x[2 * i + 1] = __builtin_bit_cast(float, w[i] & 0xffff0000u); }
        float ss = 0.f;
#pragma unroll
        for (int e = 0; e < 8; ++e) ss += x[e] * x[e];
        ss = row16_sum(ss); const float r = 1.f / sqrtf(ss * (1.f / 128.f) + EPS);
        float o[8];
#pragma unroll
        for (int e = 0; e < 8; ++e) { const float y = x[e] * r * g[e]; const float py = dpp_f<0x128>(y); o[e] = y * cs[e] + py * sn[e]; }
        u32x4 ow; ow.x = pk2(o[0], o[1]); ow.y = pk2(o[2], o[3]); ow.z = pk2(o[4], o[5]); ow.w = pk2(o[6], o[7]);
        *(u32x4*)(seg + (it * 4 + grp) * 128 + c * 8) = ow;
        if constexpr (F8) *(u32x2*)(k8 + (it * 4 + grp) * 128 + c * 8) = to_fp8x8(o);
    }
}
__device__ __forceinline__ void post_token(int pos, const float* gaq, const float* gak, const float* gbq, const float* gbk, const float* gik,
                                           bf16_t* qrow, const float* irow, bf16_t* iq, bf16_t* ik, float* iw, unsigned char* k8, unsigned char* v8, int lane) {
    const float pf = (float)pos; const int c = lane & 15, grp = lane >> 4; const float sgn = (c < 8) ? -1.f : 1.f;
    float cs[8], sn[8];
#pragma unroll
    for (int e = 0; e < 8; ++e) { float s_; rope_cs(pf * INVF[8 * (c & 7) + e], cs[e], s_); sn[e] = s_ * sgn; }
    post_segment<3, false>(qrow + COL_AQ, gaq, cs, sn, c, grp);
    post_segment<3, false>(qrow + COL_AK, gak, cs, sn, c, grp);
    post_segment<2, false>(qrow + COL_BQ, gbq, cs, sn, c, grp);
    post_segment<2, true>(qrow + COL_BK, gbk, cs, sn, c, grp, k8);
    float ci[4], si[4];
#pragma unroll
    for (int e = 0; e < 4; ++e) { float s_; rope_cs(pf * INVF[2 * ((4 * c + e) & 31)], ci[e], s_); si[e] = s_ * sgn; }
    f32x4 xi[4];
#pragma unroll
    for (int it = 0; it < 4; ++it) xi[it] = *(const f32x4*)(irow + (it * 4 + grp) * 64 + 4 * c);
    const f32x4 xk = *(const f32x4*)(irow + 1024 + 4 * c);
#pragma unroll
    for (int it = 0; it < 4; ++it) { float o[4];
#pragma unroll
        for (int e = 0; e < 4; ++e) { const float x = xi[it][e]; const float px = dpp_f<0x128>(x); o[e] = x * ci[e] + px * si[e]; }
        u32x2 ow; ow.x = pk2(o[0], o[1]); ow.y = pk2(o[2], o[3]); *(u32x2*)(iq + (it * 4 + grp) * 64 + 4 * c) = ow; }
    { const f32x4 gk = *(const f32x4*)(gik + 4 * c);
      float ss = (xk[0] * xk[0] + xk[1] * xk[1]) + (xk[2] * xk[2] + xk[3] * xk[3]); ss = row16_sum(ss); const float r = 1.f / sqrtf(ss * (1.f / 64.f) + EPS);
      float o[4];
#pragma unroll
      for (int e = 0; e < 4; ++e) { const float y = xk[e] * r * gk[e]; const float py = dpp_f<0x128>(y); o[e] = y * ci[e] + py * si[e]; }
      if (grp == 0) { u32x2 ow; ow.x = pk2(o[0], o[1]); ow.y = pk2(o[2], o[3]); *(u32x2*)(ik + 4 * c) = ow; } }
    if (lane < 16) iw[lane] = irow[1088 + lane] * 0.25f;
}

typedef float f32x2_t __attribute__((ext_vector_type(2)));
__device__ __forceinline__ void s8_issue_k(long (&kf)[16], const unsigned char* K8h, LAS const int* wsel, int j0, int n16, int slab) {
#pragma unroll
    for (int g = 0; g < 4; ++g) { const unsigned char* kp = K8h + (size_t)wsel[j0 + 16 * g + n16] * 1024 + 16 * slab;
        const u32x4 lo = *(const u32x4*)kp, hi = *(const u32x4*)(kp + 64);
        kf[g * 4 + 0] = (long)(((unsigned long long)lo.y << 32) | lo.x); kf[g * 4 + 1] = (long)(((unsigned long long)lo.w << 32) | lo.z);
        kf[g * 4 + 2] = (long)(((unsigned long long)hi.y << 32) | hi.x); kf[g * 4 + 3] = (long)(((unsigned long long)hi.w << 32) | hi.z); }
}
template <int Q> __device__ __forceinline__ void s9_issue_v(unsigned (&vv)[8], const unsigned char* V8h, LAS const unsigned* otw, int half, int l4) {
#pragma unroll
    for (int u2 = 0; u2 < 8; ++u2) vv[u2] = *(const unsigned*)(V8h + (otw[2 * (Q * 8 + u2) + half] | (unsigned)l4));
}
template <int Q> __device__ __forceinline__ void s9_pv(const unsigned (&vv)[8], LAS const float* ptw, int half, f32x2_t& oa, f32x2_t& ob) {
#pragma unroll
    for (int u2 = 0; u2 < 8; ++u2) { const float p = ptw[2 * (Q * 8 + u2) + half];
        oa = __builtin_amdgcn_cvt_pk_f32_fp8((int)vv[u2], false) * p + oa; ob = __builtin_amdgcn_cvt_pk_f32_fp8((int)vv[u2], true) * p + ob; }
}
__device__ __forceinline__ void sparse_unit7(const bf16_t* QKV, const unsigned char* K8, const unsigned char* V8, const int (&selv)[4], bf16_t* OB, LAS unsigned char* wl, int t, int h, int lane) {
    LAS int* wsel = (LAS int*)wl; LAS unsigned* otw = (LAS unsigned*)(wl + 1024); LAS float* ptw = (LAS float*)(wl + 2048);
    const int n16 = lane & 15, slab = lane >> 4, half = lane >> 5, l4 = (lane & 31) * 4;
    const bf16_t* qrow = QKV + (size_t)t * QKVW + COL_BQ + h * 128 + 16 * slab;
    long qa[4];
#pragma unroll
    for (int ks = 0; ks < 4; ++ks) { const u32x4 raw = *(const u32x4*)(qrow + 8 * (ks & 1) + 64 * (ks >> 1)); const unsigned w[4] = {raw.x, raw.y, raw.z, raw.w}; float x[8];
#pragma unroll
        for (int i = 0; i < 4; ++i) { x[2 * i] = bf2f(w[i] & 0xffffu); x[2 * i + 1] = __builtin_bit_cast(float, w[i] & 0xffff0000u); }
        const u32x2 f = to_fp8x8(x); qa[ks] = (long)(((unsigned long long)f.y << 32) | f.x); }
    const unsigned char* K8h = K8 + h * 128; const unsigned char* V8h = V8 + h * 128;
    const int n = min(256, t + 1), ns = (n + 63) >> 6;
#pragma unroll
    for (int s = 0; s < 4; ++s) { const int j = 64 * s + lane; const int id = (j < n) ? selv[s] : 0; wsel[j] = id; otw[j] = (unsigned)id * 1024u; }
    asm volatile("" ::: "memory");
    long kf[16]; unsigned va[8], vb[8];
    s8_issue_k(kf, K8h, wsel, 0, n16, slab);
    s9_issue_v<0>(va, V8h, otw, half, l4);
    float m = -INFINITY, l = 0.f; f32x2_t oa = {0.f, 0.f}, ob = {0.f, 0.f};
#pragma unroll
    for (int s = 0; s < 4; ++s) {
        if (s < ns) {
            const bool valid = (64 * s + lane) < n;
            LAS const unsigned* ot = otw + 64 * s; LAS float* pt = ptw + 64 * s;
            s9_issue_v<1>(vb, V8h, ot, half, l4);
            f32x4 acc[4];
#pragma unroll
            for (int g = 0; g < 4; ++g) { acc[g] = (f32x4){0.f, 0.f, 0.f, 0.f};
#pragma unroll
                for (int ks = 0; ks < 4; ++ks) acc[g] = __builtin_amdgcn_mfma_f32_16x16x32_fp8_fp8(qa[ks], kf[g * 4 + ks], acc[g], 0, 0, 0); }
            float sc = (slab == 0) ? acc[0][0] : (slab == 1) ? acc[1][0] : (slab == 2) ? acc[2][0] : acc[3][0];
            sc = valid ? sc * 0.08838834764831845f : -INFINITY;
            const float mn = fmaxf(m, wave_max(sc));
            const float alpha = __expf(m - mn), p = __expf(sc - mn);
            oa = oa * alpha; ob = ob * alpha; m = mn; l = l * alpha + p;
            pt[lane] = p;
            asm volatile("" ::: "memory");
            const int sn_ = (s < 3) ? (s + 1) : 3;
            s8_issue_k(kf, K8h, wsel, 64 * sn_, n16, slab);
            s9_pv<0>(va, pt, half, oa, ob);
            s9_issue_v<2>(va, V8h, ot, half, l4);
            s9_pv<1>(vb, pt, half, oa, ob);
            s9_issue_v<3>(vb, V8h, ot, half, l4);
            s9_pv<2>(va, pt, half, oa, ob);
            s9_issue_v<0>(va, V8h, otw + 64 * sn_, half, l4);
            s9_pv<3>(vb, pt, half, oa, ob);
        }
    }
    const float inv = 1.f / wave_sum(l);
    const float r0 = swap32_sum(oa.x, oa.x), r1 = swap32_sum(oa.y, oa.y), r2 = swap32_sum(ob.x, ob.x), r3 = swap32_sum(ob.y, ob.y);
    if (half == 0) { u32x2 o; o.x = pk2(r0 * inv, r1 * inv); o.y = pk2(r2 * inv, r3 * inv); *(u32x2*)(OB + (size_t)t * 1024 + h * 128 + l4) = o; }
    asm volatile("" ::: "memory");
}

typedef short v4i16_t __attribute__((ext_vector_type(4)));
constexpr int VRS = 272;
__device__ __forceinline__ void dilated_block(const bf16_t* QKV, bf16_t* OG, float* LSE, LAS unsigned char* lds, int u, int tid) {
    const int lane = tid & 63, wave = __builtin_amdgcn_readfirstlane(tid >> 6), n16 = lane & 15, slab = lane >> 4;
    const int g = u >> 9, rem = u & 511, hs = rem >> 7, pn = rem & 127;
    const int rsh = 2 * g, nbk = 128 >> rsh, p = pn >> (7 - rsh), nb = pn & (nbk - 1);
    const int head = g * 4 + hs, mbase = 128 * (nb - 1);
    __syncthreads();
#pragma unroll
    for (int i = 0; i < 8; ++i) { const int c = tid + 512 * i, row = c >> 4, ch = c & 15, m = mbase + row; u32x4 v = {0u, 0u, 0u, 0u};
        if (m >= 0) v = *(const u32x4*)(QKV + (size_t)((m << rsh) + p) * QKVW + COL_AV + head * 128 + ch * 8);
        *(LAS u32x4*)(lds + row * VRS + ch * 16) = v; }
    __syncthreads();
    const int i0 = wave * 16;
    const int tq = ((mbase + 128 + i0 + n16) << rsh) + p;
    bf16x8 qf[4];
#pragma unroll
    for (int ks = 0; ks < 4; ++ks) qf[ks] = *(const bf16x8*)(QKV + (size_t)tq * QKVW + COL_AQ + head * 128 + ks * 32 + slab * 8);
    f32x4 sacc[10];
#pragma unroll
    for (int jt = 0; jt < 9; ++jt) { int m = mbase + i0 + 16 * jt + n16; m = max(m, 0);
        const bf16_t* kp = QKV + (size_t)((m << rsh) + p) * QKVW + COL_AK + head * 128 + slab * 8;
        f32x4 acc = {0.f, 0.f, 0.f, 0.f};
#pragma unroll
        for (int ks = 0; ks < 4; ++ks) acc = __builtin_amdgcn_mfma_f32_16x16x32_bf16(*(const bf16x8*)(kp + ks * 32), qf[ks], acc, 0, 0, 0);
        sacc[jt] = acc; }
    float mx = -INFINITY;
#pragma unroll
    for (int jt = 0; jt < 9; ++jt)
#pragma unroll
        for (int i = 0; i < 4; ++i) { const int d = 128 + n16 - 16 * jt - 4 * slab - i, kk = i0 + 16 * jt + 4 * slab + i;
            const bool ok = (d >= 0) && (d <= 128) && (nb > 0 || kk >= 128);
            const float s = ok ? sacc[jt][i] * 0.08838834764831845f : -INFINITY; sacc[jt][i] = s; mx = fmaxf(mx, s); }
    { unsigned x, y; pl16(__builtin_bit_cast(unsigned, mx), __builtin_bit_cast(unsigned, mx), x, y); mx = fmaxf(__builtin_bit_cast(float, x), __builtin_bit_cast(float, y));
      pl32(__builtin_bit_cast(unsigned, mx), __builtin_bit_cast(unsigned, mx), x, y); mx = fmaxf(__builtin_bit_cast(float, x), __builtin_bit_cast(float, y)); }
    float lsum = 0.f;
#pragma unroll
    for (int jt = 0; jt < 9; ++jt)
#pragma unroll
        for (int i = 0; i < 4; ++i) { const float pe = __expf(sacc[jt][i] - mx); sacc[jt][i] = pe; lsum += pe; }
    sacc[9] = (f32x4){0.f, 0.f, 0.f, 0.f};
    lsum = swap16_sum(lsum, lsum); lsum = swap32_sum(lsum, lsum);
    if (slab == 0) LSE[(size_t)tq * 12 + head] = mx + __logf(lsum);
    f32x4 oacc[8];
#pragma unroll
    for (int c = 0; c < 8; ++c) oacc[c] = (f32x4){0.f, 0.f, 0.f, 0.f};
    const int q4 = n16 >> 2, p4 = lane & 3;
#pragma unroll
    for (int u2 = 0; u2 < 5; ++u2) {
        u32x4 pw; pw.x = pk2(sacc[2 * u2][0], sacc[2 * u2][1]); pw.y = pk2(sacc[2 * u2][2], sacc[2 * u2][3]); pw.z = pk2(sacc[2 * u2 + 1][0], sacc[2 * u2 + 1][1]); pw.w = pk2(sacc[2 * u2 + 1][2], sacc[2 * u2 + 1][3]);
        const bf16x8 pf = __builtin_bit_cast(bf16x8, pw);
        const int r0 = min(i0 + 32 * u2 + 4 * slab + q4, 255), r1 = min(i0 + 32 * u2 + 16 + 4 * slab + q4, 255);
        LAS unsigned char* a0p = lds + r0 * VRS + 8 * p4; LAS unsigned char* a1p = lds + r1 * VRS + 8 * p4;
#pragma unroll
        for (int c = 0; c < 8; ++c) {
            const v4i16_t lo = __builtin_amdgcn_ds_read_tr16_b64_v4i16((LAS v4i16_t*)(a0p + c * 32)), hi = __builtin_amdgcn_ds_read_tr16_b64_v4i16((LAS v4i16_t*)(a1p + c * 32));
            const bf16x8 vf = __builtin_shufflevector(lo, hi, 0, 1, 2, 3, 4, 5, 6, 7);
            oacc[c] = __builtin_amdgcn_mfma_f32_16x16x32_bf16(vf, pf, oacc[c], 0, 0, 0);
        }
    }
    const float inv = 1.f / lsum;
    bf16_t* op = OG + ((size_t)g * SEQ + tq) * 512 + hs * 128 + 4 * slab;
#pragma unroll
    for (int c = 0; c < 8; ++c) { u32x2 o; o.x = pk2(oacc[c][0] * inv, oacc[c][1] * inv); o.y = pk2(oacc[c][2] * inv, oacc[c][3] * inv); *(u32x2*)(op + 16 * c) = o; }
}
__device__ __forceinline__ void dilated_merge(const bf16_t* OG, const float* LSE, bf16_t* OA, int t, int hs, int lane) {
    const float l0 = LSE[(size_t)t * 12 + hs], l1 = LSE[(size_t)t * 12 + 4 + hs], l2 = LSE[(size_t)t * 12 + 8 + hs];
    const float mx = fmaxf(l0, fmaxf(l1, l2)); float w0 = __expf(l0 - mx), w1 = __expf(l1 - mx), w2 = __expf(l2 - mx);
    const float inv = 1.f / (w0 + w1 + w2); w0 *= inv; w1 *= inv; w2 *= inv;
    const size_t off = (size_t)t * 512 + hs * 128 + 2 * lane;
    const unsigned v0 = *(const unsigned*)(OG + off), v1 = *(const unsigned*)(OG + (size_t)SEQ * 512 + off), v2 = *(const unsigned*)(OG + (size_t)2 * SEQ * 512 + off);
    const float o0 = w0 * bf2f(v0 & 0xffffu) + w1 * bf2f(v1 & 0xffffu) + w2 * bf2f(v2 & 0xffffu);
    const float o1 = w0 * __builtin_bit_cast(float, v0 & 0xffff0000u) + w1 * __builtin_bit_cast(float, v1 & 0xffff0000u) + w2 * __builtin_bit_cast(float, v2 & 0xffff0000u);
    *(unsigned*)(OA + off) = pk2(o0, o1);
}

constexpr int ICAP = 512, NQI = 4;
__device__ __forceinline__ unsigned f2sort(float f) { const unsigned b = __builtin_bit_cast(unsigned, f); return b ^ ((b & 0x80000000u) ? 0xffffffffu : 0x80000000u); }
__device__ __forceinline__ float sort2f(unsigned u) { return __builtin_bit_cast(float, u ^ ((u & 0x80000000u) ? 0x80000000u : 0xffffffffu)); }
__device__ __forceinline__ void idx_compact(LAS float* bs, LAS unsigned* bi, int& cnt, float& tau, int lane) {
    unsigned u[ICAP / 64], id[ICAP / 64];
#pragma unroll
    for (int i = 0; i < ICAP / 64; ++i) { const int e = i * 64 + lane; const bool in = e < cnt; u[i] = in ? f2sort(bs[e]) : 0u; id[i] = in ? bi[e] : 0u; }
    unsigned T = 0u;
#pragma unroll 1
    for (int bit = 31; bit >= 0; --bit) { const unsigned cand = T | (1u << bit); int c = 0;
#pragma unroll
        for (int i = 0; i < ICAP / 64; ++i) c += __popcll(__ballot(u[i] >= cand));
        if (c >= 256) T = cand; if (c == 256) break; }
    int ngt = 0;
#pragma unroll
    for (int i = 0; i < ICAP / 64; ++i) ngt += __popcll(__ballot(u[i] > T));
    const int need_eq = 256 - ngt;
    int base = 0, eqbase = 0;
    __builtin_amdgcn_wave_barrier();
#pragma unroll
    for (int i = 0; i < ICAP / 64; ++i) {
        const bool gt = u[i] > T, eq = u[i] == T;
        const unsigned long long em = __ballot(eq); const int eqpos = eqbase + lane_prefix(em); eqbase += __popcll(em);
        const bool keep = gt || (eq && eqpos < need_eq);
        const unsigned long long km = __ballot(keep); const int pos = base + lane_prefix(km); base += __popcll(km);
        if (keep) { bs[pos] = sort2f(u[i]); bi[pos] = id[i]; }
    }
    __builtin_amdgcn_wave_barrier();
    cnt = 256; tau = sort2f(T);
}
__device__ __forceinline__ void idx_load(bf16x8 (&f)[8], const bf16_t* IK, int kb, int n16, int slab) {
#pragma unroll
    for (int g = 0; g < 4; ++g) { const bf16_t* kp = IK + (size_t)(kb * 64 + g * 16 + n16) * 64 + slab * 8; f[2 * g] = *(const bf16x8*)kp; f[2 * g + 1] = *(const bf16x8*)(kp + 32); }
}
__device__ __forceinline__ void idx_wait8(bf16x8 (&)[8]) {}
__device__ __forceinline__ void idx_wait0(bf16x8 (&)[8], bf16x8 (&)[8]) {}
typedef _Float16 h2_t __attribute__((ext_vector_type(2)));
typedef _Float16 h4_t __attribute__((ext_vector_type(4)));
__device__ __forceinline__ float idx_score(const bf16x8 (&f)[8], const bf16x8 a0, const bf16x8 a1, const h4_t (&wa)[4]) {
    f32x4 s = {0.f, 0.f, 0.f, 0.f}; const h2_t z = {(_Float16)0, (_Float16)0};
#pragma unroll
    for (int g = 0; g < 4; ++g) {
        f32x4 acc = {0.f, 0.f, 0.f, 0.f};
        acc = __builtin_amdgcn_mfma_f32_16x16x32_bf16(a0, f[2 * g], acc, 0, 0, 0);
        acc = __builtin_amdgcn_mfma_f32_16x16x32_bf16(a1, f[2 * g + 1], acc, 0, 0, 0);
        h2_t lo = {(_Float16)acc[0], (_Float16)acc[1]}, hi = {(_Float16)acc[2], (_Float16)acc[3]};
        lo = __builtin_elementwise_max(lo, z); hi = __builtin_elementwise_max(hi, z);
        const h4_t bb = {lo[0], lo[1], hi[0], hi[1]};
        s = __builtin_amdgcn_mfma_f32_16x16x16f16(wa[g], bb, s, 0, 0, 0);
    }
    return s[0];
}
__device__ __forceinline__ void idx_append(float score, LAS float* bs, LAS unsigned* bi, int& cnt, float& tau, int kb, int t, int lane) {
    const int kidx = kb * 64 + lane;
    const bool valid = (kidx <= t) && (score > tau);
    const unsigned long long vm = __ballot(valid); const int pos = cnt + lane_prefix(vm);
    if (valid) { bs[pos] = score; bi[pos] = (unsigned)kidx; }
    cnt += __popcll(vm);
    __builtin_amdgcn_wave_barrier();
    if (cnt > ICAP - 64) idx_compact(bs, bi, cnt, tau, lane);
}
__device__ __forceinline__ void indexer_unit(const bf16_t* IQ, const bf16_t* IK, const float* IW, unsigned short* SEL, LAS unsigned char* wlds, int t0, int lane) {
    const int n16 = lane & 15, slab = lane >> 4;
    bf16x8 a0[NQI], a1[NQI]; h4_t wa[NQI][4]; int cnt[NQI]; float tau[NQI];
#pragma unroll
    for (int q = 0; q < NQI; ++q) { const size_t t = (size_t)(t0 + q);
        a0[q] = *(const bf16x8*)(IQ + t * 1024 + n16 * 64 + slab * 8); a1[q] = *(const bf16x8*)(IQ + t * 1024 + n16 * 64 + 32 + slab * 8);
        const f32x4 wv = *(const f32x4*)(IW + t * 16 + slab * 4); const h4_t wh = {(_Float16)wv[0], (_Float16)wv[1], (_Float16)wv[2], (_Float16)wv[3]};
        const h4_t hz = {(_Float16)0, (_Float16)0, (_Float16)0, (_Float16)0};
#pragma unroll
        for (int g = 0; g < 4; ++g) wa[q][g] = (n16 == 4 * g) ? wh : hz;
        cnt[q] = 0; tau[q] = -INFINITY; }
    const int nkb = t0 / 64 + 1;
#pragma unroll
    for (int q = 0; q < NQI; ++q) asm volatile("" :: "v"(a0[q]), "v"(a1[q]), "v"(wa[q][0]), "v"(wa[q][1]), "v"(wa[q][2]), "v"(wa[q][3]));
    bf16x8 fa[8], fb[8];
#pragma unroll
    for (int i = 0; i < 8; ++i) { fa[i] = (bf16x8){0, 0, 0, 0, 0, 0, 0, 0}; fb[i] = fa[i]; }
    idx_load(fa, IK, 0, n16, slab);
#pragma unroll 1
    for (int kb = 0; kb < nkb; kb += 2) {
        idx_load(fb, IK, min(kb + 1, nkb - 1), n16, slab);
        idx_wait8(fa);
        { float sc[NQI];
#pragma unroll
          for (int q = 0; q < NQI; ++q) sc[q] = idx_score(fa, a0[q], a1[q], wa[q]);
#pragma unroll
          for (int q = 0; q < NQI; ++q) idx_append(sc[q], (LAS float*)(wlds + q * 4096), (LAS unsigned*)(wlds + q * 4096 + 2048), cnt[q], tau[q], kb, t0 + q, lane); }
        idx_load(fa, IK, min(kb + 2, nkb - 1), n16, slab);
        idx_wait8(fb);
        if (kb + 1 < nkb) {
            float sc[NQI];
#pragma unroll
            for (int q = 0; q < NQI; ++q) sc[q] = idx_score(fb, a0[q], a1[q], wa[q]);
#pragma unroll
            for (int q = 0; q < NQI; ++q) idx_append(sc[q], (LAS float*)(wlds + q * 4096), (LAS unsigned*)(wlds + q * 4096 + 2048), cnt[q], tau[q], kb + 1, t0 + q, lane);
        }
    }
    idx_wait0(fa, fb);
#pragma unroll
    for (int q = 0; q < NQI; ++q) {
        LAS float* bs = (LAS float*)(wlds + q * 4096); LAS unsigned* bi = (LAS unsigned*)(wlds + q * 4096 + 2048);
        if (cnt[q] > 256) idx_compact(bs, bi, cnt[q], tau[q], lane);
        __builtin_amdgcn_wave_barrier();
        unsigned short* sel = SEL + (size_t)(t0 + q) * 256;
#pragma unroll
        for (int j = 0; j < 4; ++j) { const int e = j * 64 + lane; if (e < cnt[q]) sel[e] = (unsigned short)bi[e]; }
    }
    __builtin_amdgcn_wave_barrier();
}

#define RLX_AGENT __ATOMIC_RELAXED, __HIP_MEMORY_SCOPE_AGENT
#define XB_TMO      128
#define XB_XCNT(j)  (256  + 64 * (j))
#define XB_XSUB(j)  (1280 + 64 * (j))
#define XB_XGEN(j)  (2304 + 64 * (j))
#define XB_TOP      3328
#define XB_TOPGEN   3392
#define XCD_BAR_WORDS 3456
#define XB_SPIN_CAP (1u << 18)

__device__ __forceinline__ unsigned xb_ld(unsigned* p)              { return __hip_atomic_load(p, __ATOMIC_RELAXED, __HIP_MEMORY_SCOPE_AGENT); }
__device__ __forceinline__ unsigned xb_add(unsigned* p, unsigned v) { return __hip_atomic_fetch_add(p, v, __ATOMIC_RELAXED, __HIP_MEMORY_SCOPE_AGENT); }
__device__ __forceinline__ unsigned xb_xcc_id() { return (unsigned)__builtin_amdgcn_s_getreg((3 << 11) | 20) & 0xFu; }
#define XB_SPIN(cond, bar) do { unsigned _sp = 0; while (cond) { __builtin_amdgcn_s_sleep(1); \
    if ((++_sp & 255u) == 0u) { if (xb_ld(&(bar)[XB_TMO])) break; if (_sp > XB_SPIN_CAP) { atomicAdd(&(bar)[XB_TMO], 1u); break; } } } } while (0)

struct XcdBarrier {
    unsigned* bar; unsigned x;
    volatile LAS unsigned* st;
};

__device__ __forceinline__ XcdBarrier xcd_barrier_post(unsigned* bar, volatile LAS unsigned* st) {
    XcdBarrier b; b.bar = bar; b.x = xb_xcc_id(); b.st = st;
    if (threadIdx.x == 0) (void)xb_add(&bar[XB_XCNT(b.x)], 1u);
    return b;
}
__device__ __forceinline__ void xcd_barrier_complete(unsigned* bar, unsigned x, unsigned& nloc, unsigned& nx) {
    const unsigned G = gridDim.x * gridDim.y * gridDim.z;
    unsigned sum, cnt, mine, sp = 0u;
    for (;;) {
        sum = 0u; cnt = 0u; mine = 0u;
#pragma unroll
        for (unsigned j = 0; j < 16; ++j) { const unsigned c = xb_ld(&bar[XB_XCNT(j)]); sum += c; cnt += (c > 0u) ? 1u : 0u; mine = (j == x) ? c : mine; }
        if (sum == G) break;
        __builtin_amdgcn_s_sleep(1);
        if ((++sp & 255u) == 0u) { if (xb_ld(&bar[XB_TMO])) break; if (sp > XB_SPIN_CAP) { atomicAdd(&bar[XB_TMO], 1u); break; } }
    }
    nloc = mine > 0u ? mine : 1u; nx = cnt > 0u ? cnt : 1u;
}

__device__ __forceinline__ void xcd_barrier(const XcdBarrier& b) {
    asm volatile("s_waitcnt vmcnt(0)" ::: "memory");
    __syncthreads();
    if (threadIdx.x == 0) {
        unsigned* bar = b.bar;
        __builtin_amdgcn_s_waitcnt(0);
        unsigned nloc = b.st[0], nx = b.st[1];
        if (nloc == 0u) { xcd_barrier_complete(bar, b.x, nloc, nx); b.st[0] = nloc; b.st[1] = nx; }
        const unsigned old = xb_add(&bar[XB_XSUB(b.x)], 1u);
        const unsigned gen = old / nloc;
        if (old + 1u == (gen + 1u) * nloc) {
            __builtin_amdgcn_fence(__ATOMIC_RELEASE, "agent");
            asm volatile("s_waitcnt vmcnt(0)" ::: "memory");
            const unsigned og = xb_add(&bar[XB_TOP], 1u);
            const unsigned tg = og / nx;
            if (og + 1u == (tg + 1u) * nx) xb_add(&bar[XB_TOPGEN], 1u);
            else XB_SPIN(xb_ld(&bar[XB_TOPGEN]) == tg, bar);
            __builtin_amdgcn_fence(__ATOMIC_ACQUIRE, "agent");
            xb_add(&bar[XB_XGEN(b.x)], 1u);
            asm volatile("s_waitcnt vmcnt(0)" ::: "memory");
        } else {
            XB_SPIN(xb_ld(&bar[XB_XGEN(b.x)]) == gen, bar);
            __builtin_amdgcn_fence(__ATOMIC_ACQUIRE, "agent");
            asm volatile("s_waitcnt vmcnt(0)" ::: "memory");
        }
    }
    __syncthreads();
}

#ifndef REP_IDX
#define REP_IDX 1
#endif
#ifndef REP_DIL
#define REP_DIL 1
#endif
#ifndef REP_SP
#define REP_SP 1
#endif
#ifndef REP_POST
#define REP_POST 1
#endif
#ifndef REP_PREP
#define REP_PREP 1
#endif
#ifndef REP_P
#define REP_P 1
#endif
#ifndef REP_N
#define REP_N 1
#endif
#ifndef REP_G
#define REP_G 1
#endif
#ifndef PHMASK
#define PHMASK 0xFFFF
#endif
#define PHON(k) ((PHMASK >> (k)) & 1)
struct Args { const float* in[18]; float* out; unsigned char* ws; int ph_lo, ph_hi; };
enum { I_X = 0, I_C, I_POS, I_WADA, I_BADA, I_WIN, I_GAQ, I_GAK, I_GBQ, I_GBK, I_GIK, I_WG, I_BG, I_WPA, I_WPB, I_WO, I_WUP, I_WDN };

__global__ void __launch_bounds__(NTHREADS, 2) mega(Args a) {
    extern __shared__ __attribute__((aligned(16))) unsigned char lds_raw[];
    LAS unsigned char* lds = (LAS unsigned char*)lds_raw;
    cg::grid_group grid = cg::this_grid();
    const int G = gridDim.x, NGW = G * NWAVES;
    unsigned char* ws = a.ws;
    float* mod = (float*)(ws + WS_MOD);
    bf16_t* H = (bf16_t*)(ws + WS_H); bf16_t* QKV = (bf16_t*)(ws + WS_QKV); float* IDXF = (float*)(ws + WS_IDXF); bf16_t* HID = (bf16_t*)(ws + WS_HID);
    bf16_t* IQ = (bf16_t*)(ws + WS_IQ); bf16_t* IK = (bf16_t*)(ws + WS_IK); float* IW = (float*)(ws + WS_IW); unsigned short* SEL = (unsigned short*)(ws + WS_SEL);
    bf16_t* OA = (bf16_t*)(ws + WS_OA); bf16_t* OB = (bf16_t*)(ws + WS_OB); bf16_t* GT = (bf16_t*)(ws + WS_G); bf16_t* MRG = (bf16_t*)(ws + WS_MRG); bf16_t* OG = (bf16_t*)(ws + WS_OG); float* LSE = (float*)(ws + WS_LSE); unsigned char* K8 = ws + WS_K8; unsigned char* V8 = ws + WS_V8; unsigned char* H8 = ws + WS_H8; float* RS = (float*)(ws + WS_RS); float* BVEC = (float*)(ws + WS_BVEC);

    { volatile LAS unsigned* st = (volatile LAS unsigned*)(lds + 131072 + 64);
      if (threadIdx.x < 2) st[threadIdx.x] = 0u;
      __syncthreads(); }
    const XcdBarrier xb = xcd_barrier_post((unsigned*)(ws + WS_BAR), (volatile LAS unsigned*)(lds + 131072 + 64));
    for (int ph = a.ph_lo; ph < a.ph_hi; ++ph) {
        int tid_ = threadIdx.x; asm volatile("" : "+v"(tid_)); const int tid = tid_, lane = tid & 63, wave = __builtin_amdgcn_readfirstlane(tid >> 6);
        const int gw = blockIdx.x * NWAVES + wave;
        if (ph == 0) { if (PHON(10)) { for (int rep = 0; rep < REP_PREP; ++rep) {
            for (int it = blockIdx.x; it < 2 * 384; it += G) mod_item(a.in[I_C], a.in[I_WADA], a.in[I_BADA], mod, (LAS float*)lds, it, tid);
            LAS float* scr = (LAS float*)(lds + wave * 16384);
            constexpr int I_IN8 = 32 * (QKVW / 32), I_I16 = 32 * (IDXW / 32), I_G8 = 32 * 128, I_PA = 8 * 64, I_PB = 16 * 64, I_O = 32 * 64, I_UP = 32 * 256, I_DN = 128 * 64;
            constexpr int PER_LAYER = I_IN8 + I_I16 + I_G8 + I_PA + I_PB + I_O + I_UP + I_DN;
            for (int it = gw; it < 2 * PER_LAYER; it += NGW) {
                const int l = it / PER_LAYER; int r = it % PER_LAYER; unsigned char* wl = ws + WS_W + (size_t)l * W_LAYER;
                const float* win = a.in[I_WIN] + (size_t)l * DM * NIN;
                if (r < I_IN8) { transpose_item<true>(win, NIN, DM, QKVW, QKVW, wl + W_IN8, scr, r, lane); continue; } r -= I_IN8;
                if (r < I_I16) { transpose_item<false>(win + QKVW, NIN, DM, NIN - QKVW, IDXW, wl + W_I16, scr, r, lane); continue; } r -= I_I16;
                if (r < I_G8) { transpose_item<true>(a.in[I_WG] + (size_t)l * DM * 4096, 4096, DM, 4096, 4096, wl + W_G8, scr, r, lane); continue; } r -= I_G8;
                if (r < I_PA) { transpose_item<false>(a.in[I_WPA] + (size_t)l * 512 * DM, DM, 512, DM, DM, wl + W_PA, scr, r, lane); continue; } r -= I_PA;
                if (r < I_PB) { transpose_item<false>(a.in[I_WPB] + (size_t)l * 1024 * DM, DM, 1024, DM, DM, wl + W_PB, scr, r, lane); continue; } r -= I_PB;
                if (r < I_O) { transpose_item<false>(a.in[I_WO] + (size_t)l * DM * DM, DM, DM, DM, DM, wl + W_O, scr, r, lane); continue; } r -= I_O;
                if (r < I_UP) { transpose_item<false>(a.in[I_WUP] + (size_t)l * DM * HIDN, HIDN, DM, HIDN, HIDN, wl + W_UP, scr, r, lane); continue; } r -= I_UP;
                transpose_item<false>(a.in[I_WDN] + (size_t)l * HIDN * DM, DM, HIDN, DM, DM, wl + W_DN, scr, r, lane);
            }
            __syncthreads(); } }
        } else {
            const int q = ph - 1, bl = q / 10, k = q % 10, b = bl >> 1, l = bl & 1;
            const unsigned char* wl = ws + WS_W + (size_t)l * W_LAYER;
            const float* md = mod + ((size_t)l * 2 + b) * NMOD;
            float* outb = a.out + (size_t)b * SEQ * DM;
            const float* xin = (l == 0) ? a.in[I_X] + (size_t)b * SEQ * DM : outb;
            if (k == 0) { if (PHON(0)) {
                for (int rep = 0; rep < REP_N; ++rep) for (int t = gw; t < SEQ; t += NGW) norm_row<true>(xin + (size_t)t * DM, md, md + DM, H + (size_t)t * DM, H8 + (size_t)t * DM, lane);
                for (int i = gw * 64 + lane; i < SEQ; i += NGW * 64) RS[i] = 0.f;
                { const bf16_t* WupT = (const bf16_t*)(wl + W_UP); const float* sh2 = md + 3 * DM;
                  for (int n = gw; n < HIDN; n += NGW) { const u32x4* wrow = (const u32x4*)(WupT + (size_t)n * DM); float s = 0.f;
#pragma unroll
                      for (int j = 0; j < 4; ++j) { const u32x4 w = wrow[lane + 64 * j]; const f32x4 h0 = *(const f32x4*)(sh2 + 8 * (lane + 64 * j)), h1 = *(const f32x4*)(sh2 + 8 * (lane + 64 * j) + 4);
                          s += (bf2f(w.x & 0xffffu) * h0[0] + __builtin_bit_cast(float, w.x & 0xffff0000u) * h0[1]) + (bf2f(w.y & 0xffffu) * h0[2] + __builtin_bit_cast(float, w.y & 0xffff0000u) * h0[3])
                             + (bf2f(w.z & 0xffffu) * h1[0] + __builtin_bit_cast(float, w.z & 0xffff0000u) * h1[1]) + (bf2f(w.w & 0xffffu) * h1[2] + __builtin_bit_cast(float, w.w & 0xffff0000u) * h1[3]); }
                      s = wave_sum(s); if (lane == 0) BVEC[n] = s; } }
            } } else if (k == 1) { if (PHON(1)) {
                for (int rep = 0; rep < REP_G; ++rep) {
                { Epi<0> E{QKV, nullptr, (const bf16_t*)V8, nullptr, nullptr, 1.f / W8_SCALE}; run_gemm<0, true>(lds, H8, wl + W_IN8, QKVW, DM / 2, E); }
                { Epi<6> E{nullptr, IDXF, nullptr, nullptr, nullptr, 1.f}; run_gemm<6>(lds, H, wl + W_I16, IDXW, DM, E, (int)gridDim.x / 2); }
                { Epi<1> E{GT, nullptr, nullptr, a.in[I_BG] + (size_t)l * 4096, nullptr, 1.f / W8_SCALE}; run_gemm<1, true>(lds, H8, wl + W_G8, 4096, DM / 2, E); }
                }
            } } else if (k == 2) { if (PHON(2)) {
                const int* pos = (const int*)a.in[I_POS] + (size_t)b * SEQ;
                for (int rep = 0; rep < REP_POST; ++rep) for (int t = gw; t < SEQ; t += NGW)
                    post_token(pos[t], a.in[I_GAQ] + l * 128, a.in[I_GAK] + l * 128, a.in[I_GBQ] + l * 128, a.in[I_GBK] + l * 128, a.in[I_GIK] + l * 64,
                               QKV + (size_t)t * QKVW, IDXF + (size_t)t * IDXW, IQ + (size_t)t * 1024, IK + (size_t)t * 64, IW + (size_t)t * 16, K8 + (size_t)t * 1024, V8 + (size_t)t * 1024, lane);
            } } else if (k == 3) { if (PHON(3)) {
                for (int rep = 0; rep < REP_DIL; ++rep) for (int u = blockIdx.x; u < 1536; u += G) dilated_block(QKV, OG, LSE, lds, u, tid);
                __syncthreads();
                for (int rep = 0; rep < REP_IDX; ++rep) for (int pr = gw; pr < SEQ / NQI / 2; pr += NGW) {
                    indexer_unit(IQ, IK, IW, SEL, lds + wave * 16384, (SEQ / NQI - 1 - pr) * NQI, lane); indexer_unit(IQ, IK, IW, SEL, lds + wave * 16384, pr * NQI, lane); }
                __syncthreads();
            } } else if (k == 4) { if (PHON(4)) {
                const int h = blockIdx.x & 7, qg = (blockIdx.x >> 3) * NWAVES + wave, nqg = ((G + 7) >> 3) * NWAVES;
                for (int u = gw; u < SEQ * 4; u += NGW) dilated_merge(OG, LSE, OA, u >> 2, u & 3, lane);
                for (int rep = 0; rep < REP_SP; ++rep)
                if ((G & 7) == 0) { int seln[4];
#pragma unroll
                    for (int s = 0; s < 4; ++s) seln[s] = (int)SEL[(size_t)min(qg, SEQ - 1) * 256 + 64 * s + lane];
                    for (int t = qg; t < SEQ; t += nqg) { int selc[4];
#pragma unroll
                        for (int s = 0; s < 4; ++s) selc[s] = seln[s];
                        const int tn = min(t + nqg, SEQ - 1);
#pragma unroll
                        for (int s = 0; s < 4; ++s) seln[s] = (int)SEL[(size_t)tn * 256 + 64 * s + lane];
                        sparse_unit7(QKV, K8, V8, selc, OB, lds + wave * 4096, t, h, lane); } }
                else { for (int u = gw; u < SEQ * 8; u += NGW) { const int t = u >> 3; int selc[4];
#pragma unroll
                        for (int s = 0; s < 4; ++s) selc[s] = (int)SEL[(size_t)t * 256 + 64 * s + lane];
                        sparse_unit7(QKV, K8, V8, selc, OB, lds + wave * 4096, t, u & 7, lane); } }
            } } else if (k == 5) { if (PHON(5)) {
                for (int rep = 0; rep < REP_P; ++rep) {
                { Epi<2> E{MRG, nullptr, GT, nullptr, nullptr, 1.f}; run_gemm<2>(lds, OA, wl + W_PA, DM, 512, E); }
                { Epi<3> E{MRG, nullptr, GT, nullptr, nullptr, 1.f}; run_gemm<3>(lds, OB, wl + W_PB, DM, 1024, E); }
                }
            } } else if (k == 6) { if (PHON(6)) {
                Epi<7> E{H, outb, nullptr, md + 2 * DM, xin, 1.f, md + 4 * DM, RS}; run_gemm<7>(lds, MRG, wl + W_O, DM, DM, E);
            } } else if (k == 7) { if (PHON(7)) {
            } } else if (k == 8) { if (PHON(8)) {
                for (int rep = 0; rep < REP_G; ++rep) {                 Epi<8> E{HID, nullptr, nullptr, BVEC, nullptr, 1.f, nullptr, RS}; run_gemm<8>(lds, H, wl + W_UP, HIDN, DM, E); }
            } } else { if (PHON(9)) {
                Epi<4> E{nullptr, outb, nullptr, md + 5 * DM, outb, 1.f}; run_gemm<4>(lds, HID, wl + W_DN, DM, HIDN, E);
            } }
        }
        if (ph + 1 < a.ph_hi && !(ph > 0 && (ph - 1) % 10 == 7)) { if (ph == a.ph_lo) grid.sync(); else xcd_barrier(xb); }
    }
}

#ifndef MK_MULTI
#define MK_MULTI 0
#endif
extern "C" void kernel_launch(void* const* d_in, const int* in_sizes, int n_in, void* d_out, int out_size, void* d_ws, size_t ws_size, hipStream_t stream) {
    static int grid = 0;
    if (grid == 0) {
        if (n_in != 18 || out_size != NB * SEQ * DM || ws_size < WS_END) { fprintf(stderr, "kernel_launch: unexpected shapes (n_in %d out %d ws %zu)\n", n_in, out_size, ws_size); grid = -1; return; }
        int dev = 0, cus = 0, per_cu = 0;
        (void)hipGetDevice(&dev); (void)hipDeviceGetAttribute(&cus, hipDeviceAttributeMultiprocessorCount, dev);
        (void)hipFuncSetAttribute((const void*)mega, hipFuncAttributeMaxDynamicSharedMemorySize, LDS_BYTES);
        if (hipOccupancyMaxActiveBlocksPerMultiprocessor(&per_cu, (const void*)mega, NTHREADS, LDS_BYTES) != hipSuccess || per_cu < 1) per_cu = 1;
        (void)hipGetLastError();
        grid = cus * per_cu;
    }
    if (grid < 0) return;
    Args a{};
    for (int i = 0; i < 18; ++i) a.in[i] = (const float*)d_in[i];
    a.out = (float*)d_out; a.ws = (unsigned char*)d_ws;
#if MK_MULTI
    for (int ph = 0; ph < N_PHASES; ++ph) { a.ph_lo = ph; a.ph_hi = ph + 1; hipLaunchKernelGGL(mega, dim3(grid), dim3(NTHREADS), LDS_BYTES, stream, a); }
#else
    (void)hipMemsetAsync((unsigned char*)d_ws + WS_BAR, 0, BAR_BYTES, stream);
    a.ph_lo = 0; a.ph_hi = N_PHASES; void* args[] = {&a};
    hipError_t e = hipLaunchCooperativeKernel((const void*)mega, dim3(grid), dim3(NTHREADS), args, LDS_BYTES, stream);
    if (e != hipSuccess) fprintf(stderr, "cooperative launch failed: %s (grid %d)\n", hipGetErrorString(e), grid);
#endif
}
```

```cpp
#include <hip/hip_runtime.h>
#include <hip/hip_cooperative_groups.h>
#include <cstdio>
#include <cstdint>
namespace cg = cooperative_groups;
namespace pg8 {
#define PG8_LAS __attribute__((address_space(3)))
typedef unsigned short bf16_t;
typedef short bf16x8 __attribute__((ext_vector_type(8)));
typedef float f32x4 __attribute__((ext_vector_type(4)));
typedef unsigned u32x4 __attribute__((ext_vector_type(4)));
constexpr int BM = 256, BK = 64, HALF = 128, HTB = HALF * BK * 2  , STAGE_BYTES = 8 * HTB, NXCD = 8, WGM = 4;

__host__ __device__ __forceinline__ int lds_byte(int r, int c) { const int st = (r >> 4) * 2 + (c >> 5), rr = r & 15, cc = c & 31, ob = rr * 64 + cc * 2; return st * 1024 + (ob ^ (((ob >> 9) & 1) << 5)); }
__host__ __device__ __forceinline__ void stage_rc(int b, int& R, int& C) { const int st = b / 1024, sb = b % 1024, swz = sb ^ (((sb >> 9) & 1) << 5); R = (st >> 1) * 16 + swz / 64; C = (st & 1) * 32 + (swz % 64) / 2; }
__host__ __device__ __forceinline__ int perm32(int rho) { const int n = rho >> 4, i = rho & 15; return 8 * (i >> 2) + 4 * n + (i & 3); }

struct Unit { int pm, pn; };
struct Gemm { const bf16_t* A; const bf16_t* Bt; int M, N, K; };

struct StaticOrder {
    int nM, nN, nwg, G, c;
    __host__ __device__ void init(int M, int N, int G_, int c_) { nM = M / BM; nN = N / BM; nwg = nM * nN; G = G_; c = c_; }
    __host__ __device__ bool next(int i, Unit& u) const {
        const long L = (long)i * G + c; if (L >= nwg) return false;
        int wgid = (int)L; { const int q = nwg / NXCD, r = nwg % NXCD, xcd = wgid % NXCD, off = wgid / NXCD; wgid = (xcd < r ? xcd * (q + 1) : r * (q + 1) + (xcd - r) * q) + off; }
        const int nig = WGM * nN, gid = wgid / nig, fm = gid * WGM, gsz = (nM - fm) < WGM ? (nM - fm) : WGM;
        u.pm = fm + ((wgid % nig) % gsz); u.pn = (wgid % nig) / gsz; return true;
    }
    __device__ __forceinline__ void a_ready(const Unit&) const {}
    __device__ __forceinline__ void done(const Unit&) const {}
};

__device__ __forceinline__ unsigned cvt_pk_bf16(float lo, float hi) { unsigned r; asm volatile("v_cvt_pk_bf16_f32 %0, %1, %2" : "=v"(r) : "v"(lo), "v"(hi)); return r; }
template <class Epi, class Sched, bool ALIGN_EPI = false, bool SP2 = false, bool F8 = false>
__device__ __forceinline__ void gemm_phase(PG8_LAS unsigned char* lds, const Gemm g, const Sched& S, const Epi& E) {
    int tid_ = threadIdx.x; asm volatile("" : "+v"(tid_)); const int tid = tid_, wid = __builtin_amdgcn_readfirstlane(tid >> 6), lane = tid & 63, wr = wid >> 2, wc = wid & 3, fr = lane & 15, fq = lane >> 4;
    const int K = g.K, nt = K / BK;
    unsigned voffA[2], voffB[2];
#pragma unroll
    for (int i = 0; i < 2; ++i) { int R, C; stage_rc(tid * 16 + i * 8192, R, C); const int Rb = Epi::PERM ? ((R & ~31) + perm32(R & 31)) : R;
        voffA[i] = (unsigned)(R * K + C) * 2u; voffB[i] = (unsigned)(Rb * K + C) * 2u; }
    const size_t kstep = (size_t)(BK * 2);
    const size_t hstep = (size_t)HALF * K * 2;
    const size_t tstep = 2 * hstep;
    const unsigned ldsw = (unsigned)wid * 1024u;
    const int aoff = lds_byte(wr * 64 + fr, fq * 8), boff = lds_byte(wc * 32 + fr, fq * 8);
#define PG8_SA(b, h) (((b) * 2 + (h)) * HTB)
#define PG8_SB(b, h) ((4 + (b) * 2 + (h)) * HTB)
#define PG8_STAGE(bufoff, gbase, voff) do { _Pragma("unroll") for (int _i = 0; _i < 2; ++_i) \
        __builtin_amdgcn_global_load_lds((const unsigned*)((const char*)(gbase) + (voff)[_i]), (PG8_LAS unsigned*)(lds + (bufoff) + ldsw + _i * 8192), 16, 0, 0); } while (0)
#define PG8_CAT8(p0, p1) __builtin_shufflevector(*(const PG8_LAS i4_t*)(p0), *(const PG8_LAS i4_t*)(p1), 0, 1, 2, 3, 4, 5, 6, 7)
#define PG8_LDA(dst, b, h) do { if constexpr (F8) { _Pragma("unroll") for (int m = 0; m < 4; ++m) dst##8[m] = PG8_CAT8(lds + PG8_SA(b, h) + aoff + m * 2048, lds + PG8_SA(b, h) + aoff + m * 2048 + 1024); } \
        else { _Pragma("unroll") for (int m = 0; m < 4; ++m) _Pragma("unroll") for (int k = 0; k < 2; ++k) dst[m][k] = *(const PG8_LAS bf16x8*)(lds + PG8_SA(b, h) + aoff + m * 2048 + k * 1024); } } while (0)
#define PG8_LDB(dst, b, h) do { if constexpr (F8) { _Pragma("unroll") for (int n = 0; n < 2; ++n) dst##8[n] = PG8_CAT8(lds + PG8_SB(b, h) + boff + n * 2048, lds + PG8_SB(b, h) + boff + n * 2048 + 1024); } \
        else { _Pragma("unroll") for (int n = 0; n < 2; ++n) _Pragma("unroll") for (int k = 0; k < 2; ++k) dst[n][k] = *(const PG8_LAS bf16x8*)(lds + PG8_SB(b, h) + boff + n * 2048 + k * 1024); } } while (0)
#define PG8_MMA(ai, bj, At, Bt) do { __builtin_amdgcn_s_setprio(1); \
        if constexpr (F8) { _Pragma("unroll") for (int m = 0; m < 4; ++m) _Pragma("unroll") for (int n = 0; n < 2; ++n) \
                asm volatile("v_mfma_scale_f32_16x16x128_f8f6f4 %0, %1, %2, %0, %3, %3 op_sel_hi:[0,0,0]" : "+v"(acc[ai][bj][m][n]) : "v"(Bt##8[n]), "v"(At##8[m]), "v"(f8scale)); } \
        else { _Pragma("unroll") for (int m = 0; m < 4; ++m) _Pragma("unroll") for (int n = 0; n < 2; ++n) _Pragma("unroll") for (int k = 0; k < 2; ++k) \
                acc[ai][bj][m][n] = __builtin_amdgcn_mfma_f32_16x16x32_bf16(Bt[n][k], At[m][k], acc[ai][bj][m][n], 0, 0, 0); } \
        __builtin_amdgcn_s_setprio(0); } while (0)
#define PG8_WAIT_V(n) asm volatile("s_waitcnt vmcnt(" #n ")" ::: "memory")
#define PG8_WAIT_L(n) asm volatile("s_waitcnt lgkmcnt(" #n ")" ::: "memory")
#define PG8_BAR __builtin_amdgcn_s_barrier()
#define PG8_SCHED __builtin_amdgcn_sched_barrier(0)
    Unit cur, nxt; int ui = 0;
    if (!S.next(0, cur)) return;
    f32x4 acc[2][2][4][2];
#pragma unroll
    for (int a = 0; a < 2; ++a)
#pragma unroll
        for (int b = 0; b < 2; ++b)
#pragma unroll
            for (int m = 0; m < 4; ++m)
#pragma unroll
                for (int n = 0; n < 2; ++n) acc[a][b][m][n] = (f32x4){0.f, 0.f, 0.f, 0.f};
    typedef int i8_t __attribute__((ext_vector_type(8))); typedef int i4_t __attribute__((ext_vector_type(4)));
    bf16x8 At[4][2], B0[2][2], B1[2][2]; i8_t At8[4], B08[2], B18[2];
    int f8scale = 0x7f7f7f7f; asm volatile("" : "+v"(f8scale));
    const char* cA = (const char*)g.A + (size_t)cur.pm * tstep; const char* cB = (const char*)g.Bt + (size_t)cur.pn * tstep;
    S.a_ready(cur);
    if constexpr (SP2) {
        PG8_STAGE(PG8_SB(0, 0), cB, voffB); PG8_STAGE(PG8_SB(0, 1), cB + hstep, voffB); PG8_STAGE(PG8_SA(0, 0), cA, voffA); PG8_STAGE(PG8_SA(0, 1), cA + hstep, voffA);
        if (wr == 1) PG8_BAR;
        PG8_WAIT_V(2); PG8_BAR;
        PG8_STAGE(PG8_SB(1, 0), cB + kstep, voffB); PG8_STAGE(PG8_SA(1, 0), cA + kstep, voffA); PG8_STAGE(PG8_SB(1, 1), cB + hstep + kstep, voffB);
        PG8_WAIT_V(6); PG8_BAR;
    } else {
        PG8_STAGE(PG8_SB(0, 0), cB, voffB); PG8_STAGE(PG8_SA(0, 0), cA, voffA); PG8_STAGE(PG8_SB(0, 1), cB + hstep, voffB); PG8_STAGE(PG8_SA(0, 1), cA + hstep, voffA);
        if (wr == 1) PG8_BAR;
        PG8_WAIT_V(4); PG8_BAR;
        PG8_STAGE(PG8_SB(1, 0), cB + kstep, voffB); PG8_STAGE(PG8_SA(1, 0), cA + kstep, voffA); PG8_STAGE(PG8_SB(1, 1), cB + hstep + kstep, voffB);
        PG8_WAIT_V(6); PG8_BAR;
    }
    for (;;) {
        const bool has_next = S.next(ui + 1, nxt);
        const char* nA = has_next ? (const char*)g.A + (size_t)nxt.pm * tstep : cA; const char* nB = has_next ? (const char*)g.Bt + (size_t)nxt.pn * tstep : cB;
        for (int t = 0; t < nt; t += 2) {
            const bool last = (t == nt - 2);
            const char* a1 = cA + (size_t)(t + 1) * kstep;
            const char* a2 = last ? nA : cA + (size_t)(t + 2) * kstep; const char* b2 = last ? nB : cB + (size_t)(t + 2) * kstep;
            const char* a3 = a2 + kstep; const char* b3 = b2 + kstep;
            if (last && has_next) S.a_ready(nxt);
            if constexpr (SP2) {
            PG8_LDB(B0, 0, 0); PG8_LDB(B1, 0, 1); PG8_SCHED; PG8_LDA(At, 0, 0); PG8_STAGE(PG8_SA(1, 1), a1 + hstep, voffA);
            PG8_WAIT_V(8); PG8_WAIT_L(0); PG8_BAR; PG8_MMA(0, 0, At, B0); PG8_MMA(0, 1, At, B1); PG8_BAR; PG8_SCHED;
            PG8_LDA(At, 0, 1); PG8_STAGE(PG8_SB(0, 0), b2, voffB); PG8_STAGE(PG8_SB(0, 1), b2 + hstep, voffB); PG8_STAGE(PG8_SA(0, 0), a2, voffA);
            PG8_WAIT_V(8); PG8_WAIT_L(0); PG8_BAR; PG8_MMA(1, 0, At, B0); PG8_MMA(1, 1, At, B1); PG8_BAR; PG8_SCHED;
            PG8_LDB(B0, 1, 0); PG8_LDB(B1, 1, 1); PG8_SCHED; PG8_LDA(At, 1, 0); PG8_STAGE(PG8_SA(0, 1), a2 + hstep, voffA);
            PG8_WAIT_V(8); PG8_WAIT_L(0); PG8_BAR; PG8_MMA(0, 0, At, B0); PG8_MMA(0, 1, At, B1); PG8_BAR; PG8_SCHED;
            PG8_LDA(At, 1, 1); PG8_STAGE(PG8_SB(1, 0), b3, voffB); PG8_STAGE(PG8_SB(1, 1), b3 + hstep, voffB); PG8_STAGE(PG8_SA(1, 0), a3, voffA);
            PG8_WAIT_V(8); PG8_WAIT_L(0); PG8_BAR; PG8_MMA(1, 0, At, B0); PG8_MMA(1, 1, At, B1); PG8_BAR; PG8_SCHED;
            } else {
            PG8_LDB(B0, 0, 0); PG8_SCHED; PG8_LDA(At, 0, 0); PG8_STAGE(PG8_SA(1, 1), a1 + hstep, voffA);
            PG8_WAIT_L(8); PG8_BAR; PG8_WAIT_L(0); PG8_MMA(0, 0, At, B0); PG8_BAR; PG8_SCHED;
            PG8_LDB(B1, 0, 1); PG8_STAGE(PG8_SB(0, 0), b2, voffB);
            PG8_BAR; PG8_WAIT_L(0); PG8_MMA(0, 1, At, B1); PG8_BAR;
            PG8_LDA(At, 0, 1); PG8_STAGE(PG8_SA(0, 0), a2, voffA);
            PG8_BAR; PG8_WAIT_L(0); PG8_MMA(1, 0, At, B0); PG8_BAR; PG8_SCHED;
            PG8_STAGE(PG8_SB(0, 1), b2 + hstep, voffB);
            PG8_WAIT_V(6); PG8_BAR; PG8_MMA(1, 1, At, B1); PG8_BAR;
            PG8_LDB(B0, 1, 0); PG8_SCHED; PG8_LDA(At, 1, 0); PG8_STAGE(PG8_SA(0, 1), a2 + hstep, voffA);
            PG8_WAIT_L(8); PG8_BAR; PG8_WAIT_L(0); PG8_MMA(0, 0, At, B0); PG8_BAR; PG8_SCHED;
            PG8_LDB(B1, 1, 1); PG8_STAGE(PG8_SB(1, 0), b3, voffB);
            PG8_BAR; PG8_WAIT_L(0); PG8_MMA(0, 1, At, B1); PG8_BAR;
            PG8_LDA(At, 1, 1); PG8_STAGE(PG8_SA(1, 0), a3, voffA);
            PG8_BAR; PG8_WAIT_L(0); PG8_MMA(1, 0, At, B0); PG8_BAR; PG8_SCHED;
            PG8_STAGE(PG8_SB(1, 1), b3 + hstep, voffB);
            PG8_WAIT_V(6); PG8_BAR; PG8_MMA(1, 1, At, B1); PG8_BAR;
            }
        }
        if constexpr (ALIGN_EPI) { if (wr == 0) PG8_BAR; }
        if constexpr (F8) asm volatile("s_nop 15\n\ts_nop 15" : "+v"(acc[1][1][0][0]), "+v"(acc[1][1][0][1]), "+v"(acc[1][1][1][0]), "+v"(acc[1][1][1][1]), "+v"(acc[1][1][2][0]), "+v"(acc[1][1][2][1]), "+v"(acc[1][1][3][0]), "+v"(acc[1][1][3][1]));
        if constexpr (!Epi::AFTER_DRAIN) { E(acc, cur, wr, wc, fr, fq); S.done(cur); }
        if (!has_next) break;
#pragma unroll
        for (int a = 0; a < 2; ++a)
#pragma unroll
            for (int b = 0; b < 2; ++b)
#pragma unroll
                for (int m = 0; m < 4; ++m)
#pragma unroll
                    for (int n = 0; n < 2; ++n) acc[a][b][m][n] = (f32x4){0.f, 0.f, 0.f, 0.f};
        cur = nxt; cA = nA; cB = nB; ++ui;
        if constexpr (ALIGN_EPI) { if (wr == 1) PG8_BAR; }
    }
    PG8_WAIT_V(0);
    if constexpr (!ALIGN_EPI) { if (wr == 0) PG8_BAR; }
    PG8_BAR;
    if constexpr (Epi::AFTER_DRAIN) { E.fused(acc, cur, wr, wc, fr, fq, lds, wid, lane); S.done(cur); }
#undef PG8_SA
#undef PG8_SB
#undef PG8_STAGE
#undef PG8_LDA
#undef PG8_CAT8
#undef PG8_LDB
#undef PG8_MMA
#undef PG8_WAIT_V
#undef PG8_WAIT_L
#undef PG8_BAR
#undef PG8_SCHED
}
}

using pg8::bf16_t; using pg8::bf16x8; using pg8::f32x4; using pg8::u32x4;
typedef unsigned u32x2 __attribute__((ext_vector_type(2)));
#define LAS __attribute__((address_space(3)))
constexpr int DM = 2048, NB = 2, SEQ = 16384, DEPTH = 2;
constexpr int NIN = 8784, NINP = 8960, QKVW = 7680, IDXW = 1280, HIDN = 8192, NMOD = 12288;
constexpr int COL_AQ = 0, COL_AK = 1536, COL_AV = 3072, COL_BQ = 4608, COL_BK = 5632, COL_BV = 6656;
constexpr float EPS = 1e-6f;
constexpr int NWAVES = 8, NTHREADS = 512;
constexpr int LDS_BYTES = 147456;
constexpr size_t MiB = 1u << 20;
constexpr size_t WS_MOD = 0, WS_RS = 256 * 1024  , WS_BVEC = 320 * 1024  , WS_BAR = 512 * 1024, BAR_BYTES = 16384, WS_W = 1 * MiB;
constexpr size_t W_I16 = 0, W_IN8 = 5 * MiB, W_G8 = 20 * MiB, W_PA = 35 * MiB, W_PB = 37 * MiB, W_O = 41 * MiB, W_UP = 49 * MiB, W_DN = 81 * MiB, W_LAYER = 113 * MiB;
constexpr float W8_SCALE = 64.f;
constexpr size_t WS_H = WS_W + 2 * W_LAYER;
constexpr size_t WS_QKV = WS_H + 64 * MiB;
constexpr size_t WS_IDXF = WS_QKV + 240 * MiB;
constexpr size_t WS_HID = WS_QKV;
constexpr size_t WS_IQ = WS_IDXF + 80 * MiB;
constexpr size_t WS_IK = WS_IQ + 32 * MiB;
constexpr size_t WS_IW = WS_IK + 2 * MiB;
constexpr size_t WS_SEL = WS_IW + 1 * MiB;
constexpr size_t WS_OA = WS_SEL + 8 * MiB;
constexpr size_t WS_OB = WS_OA + 16 * MiB;
constexpr size_t WS_G = WS_OB + 32 * MiB;
constexpr size_t WS_MRG = WS_G + 128 * MiB;
constexpr size_t WS_OG = WS_MRG + 64 * MiB;
constexpr size_t WS_LSE = WS_OG + 48 * MiB;
constexpr size_t WS_K8 = WS_LSE + 1 * MiB;
constexpr size_t WS_V8 = WS_K8 + 16 * MiB;
constexpr size_t WS_H8 = WS_V8 + 16 * MiB;
constexpr size_t WS_END = WS_H8 + 32 * MiB;
static_assert(WS_END <= (size_t)1024 * MiB, "workspace map");
constexpr int N_PHASES = 1 + NB * DEPTH * 10;

__device__ const float INVF[64] = {1.0f,0.865964353f,0.749894261f,0.649381638f,0.562341332f,0.486967534f,0.421696514f,0.365174115f,0.316227764f,0.273841977f,0.237137377f,0.2053525f,0.177827939f,0.153992653f,0.133352131f,0.115478203f,0.100000001f,0.0865964293f,0.0749894157f,0.0649381652f,0.0562341325f,0.0486967526f,0.0421696529f,0.0365174115f,0.0316227749f,0.0273841973f,0.0237137377f,0.0205352511f,0.0177827943f,0.0153992651f,0.0133352149f,0.0115478206f,0.00999999978f,0.00865964312f,0.00749894185f,0.00649381615f,0.00562341325f,0.00486967526f,0.00421696482f,0.00365174119f,0.00316227763f,0.00273841969f,0.00237137359f,0.00205352483f,0.00177827943f,0.00153992651f,0.00133352145f,0.0011547819f,0.00100000005f,0.000865964335f,0.000749894243f,0.000649381662f,0.000562341302f,0.000486967532f,0.000421696517f,0.000365174143f,0.000316227757f,0.000273841957f,0.00023713737f,0.00020535251f,0.00017782794f,0.000153992645f,0.00013335215f,0.0001154782f};

__device__ __forceinline__ float bf2f(unsigned u16) { return __builtin_bit_cast(float, u16 << 16); }
__device__ __forceinline__ unsigned f2bf(float f) { unsigned u = __builtin_bit_cast(unsigned, f); return (u + 0x7fffu + ((u >> 16) & 1u)) >> 16; }
__device__ __forceinline__ unsigned pk2(float lo, float hi) { return f2bf(lo) | (f2bf(hi) << 16); }
template <int CTRL> __device__ __forceinline__ float dpp_f(float v) { return __builtin_bit_cast(float, __builtin_amdgcn_update_dpp(0, __builtin_bit_cast(int, v), CTRL, 0xF, 0xF, true)); }
template <int CTRL> __device__ __forceinline__ int dpp_i(int v) { return __builtin_amdgcn_update_dpp(0, v, CTRL, 0xF, 0xF, true); }
__device__ __forceinline__ void pl32(unsigned a, unsigned b, unsigned& ra, unsigned& rb) { asm volatile("" : "+v"(b)); auto r = __builtin_amdgcn_permlane32_swap(a, b, false, false); ra = r[0]; rb = r[1]; asm volatile("" : "+v"(ra), "+v"(rb)); }
__device__ __forceinline__ void pl16(unsigned a, unsigned b, unsigned& ra, unsigned& rb) { asm volatile("" : "+v"(b)); auto r = __builtin_amdgcn_permlane16_swap(a, b, false, false); ra = r[0]; rb = r[1]; asm volatile("" : "+v"(ra), "+v"(rb)); }
__device__ __forceinline__ float swap32_sum(float a, float b) { unsigned x, y; pl32(__builtin_bit_cast(unsigned, a), __builtin_bit_cast(unsigned, b), x, y); return __builtin_bit_cast(float, x) + __builtin_bit_cast(float, y); }
__device__ __forceinline__ float swap16_sum(float a, float b) { unsigned x, y; pl16(__builtin_bit_cast(unsigned, a), __builtin_bit_cast(unsigned, b), x, y); return __builtin_bit_cast(float, x) + __builtin_bit_cast(float, y); }
__device__ __forceinline__ float wave_sum(float v) {
    v += dpp_f<0x128>(v); v += dpp_f<0x124>(v); v += dpp_f<0x4E>(v); v += dpp_f<0xB1>(v);
    v = swap16_sum(v, v); return swap32_sum(v, v);
}
__device__ __forceinline__ float wave_max(float v) {
    v = fmaxf(v, dpp_f<0x128>(v)); v = fmaxf(v, dpp_f<0x124>(v)); v = fmaxf(v, dpp_f<0x4E>(v)); v = fmaxf(v, dpp_f<0xB1>(v));
    unsigned x, y;
    pl16(__builtin_bit_cast(unsigned, v), __builtin_bit_cast(unsigned, v), x, y); v = fmaxf(__builtin_bit_cast(float, x), __builtin_bit_cast(float, y));
    pl32(__builtin_bit_cast(unsigned, v), __builtin_bit_cast(unsigned, v), x, y); v = fmaxf(__builtin_bit_cast(float, x), __builtin_bit_cast(float, y));
    return v;
}
__device__ __forceinline__ int wave_sum_i(int v) {
    v += dpp_i<0x128>(v); v += dpp_i<0x124>(v); v += dpp_i<0x4E>(v); v += dpp_i<0xB1>(v);
    unsigned x, y;
    pl16((unsigned)v, (unsigned)v, x, y); v = (int)(x + y);
    pl32((unsigned)v, (unsigned)v, x, y); v = (int)(x + y);
    return v;
}
__device__ __forceinline__ int lane_prefix(unsigned long long mask) { return __builtin_amdgcn_mbcnt_hi((unsigned)(mask >> 32), __builtin_amdgcn_mbcnt_lo((unsigned)mask, 0)); }
__device__ __forceinline__ void rope_cs(float ang, float& c, float& s) {
    double rev = (double)ang * 0.15915494309189535; rev -= __builtin_rint(rev); const float rf = (float)rev;
    s = __builtin_amdgcn_sinf(rf); c = __builtin_amdgcn_cosf(rf);
}

__device__ __forceinline__ u32x2 to_fp8x8(const float (&o)[8]) {
    u32x2 w; int t0 = __builtin_amdgcn_cvt_pk_fp8_f32(o[0], o[1], 0, false); t0 = __builtin_amdgcn_cvt_pk_fp8_f32(o[2], o[3], t0, true);
    int t1 = __builtin_amdgcn_cvt_pk_fp8_f32(o[4], o[5], 0, false); t1 = __builtin_amdgcn_cvt_pk_fp8_f32(o[6], o[7], t1, true); w.x = (unsigned)t0; w.y = (unsigned)t1; return w;
}

template <int MODE> struct Epi {
    static constexpr bool PERM = true, AFTER_DRAIN = false;
    bf16_t* ob; float* of; const bf16_t* aux; const float* vec; const float* xsrc; float scale; const float* vec2; float* rs;
    __device__ __forceinline__ void operator()(const f32x4 (&acc)[2][2][4][2], const pg8::Unit& u, int wr, int wc, int fr, int fq) const {
        const int row0 = u.pm * 256 + wr * 64 + fr, col0 = u.pn * 256 + wc * 32 + 8 * fq;
#pragma unroll
        for (int ai = 0; ai < 2; ++ai)
#pragma unroll
            for (int m = 0; m < 4; ++m) {
                const size_t row = (size_t)(row0 + ai * 128 + m * 16);
                float ssq = 0.f, rstd = 1.f;
                if constexpr (MODE == 8) rstd = 1.f / sqrtf(rs[row] * (1.f / DM) + EPS);
#pragma unroll
                for (int bj = 0; bj < 2; ++bj) {
                    const int col = col0 + bj * 128;
                    f32x4 v0 = acc[ai][bj][m][0], v1 = acc[ai][bj][m][1];
                    if constexpr (MODE == 0 || MODE == 1) { v0 = v0 * scale; v1 = v1 * scale; }
                    if constexpr (MODE == 6) { float* p = of + row * IDXW + col; *(f32x4*)p = v0; *(f32x4*)(p + 4) = v1; }
                    else if constexpr (MODE == 0) {
                        if (u.pn >= COL_BV / 256) {
                            const float x8[8] = {v0[0], v0[1], v0[2], v0[3], v1[0], v1[1], v1[2], v1[3]};
                            *(u32x2*)((unsigned char*)aux + row * 1024 + (col - COL_BV)) = to_fp8x8(x8);
                        } else { u32x4 w; w.x = pk2(v0[0], v0[1]); w.y = pk2(v0[2], v0[3]); w.z = pk2(v1[0], v1[1]); w.w = pk2(v1[2], v1[3]);
                            *(u32x4*)(ob + row * QKVW + col) = w; }
                    } else if constexpr (MODE == 1) {
                        const f32x4 b0 = *(const f32x4*)(vec + col), b1 = *(const f32x4*)(vec + col + 4);
                        float r[8];
#pragma unroll
                        for (int i = 0; i < 4; ++i) { r[i] = 1.f / (1.f + __expf(-(v0[i] + b0[i]))); r[4 + i] = 1.f / (1.f + __expf(-(v1[i] + b1[i]))); }
                        u32x4 w; w.x = pk2(r[0], r[1]); w.y = pk2(r[2], r[3]); w.z = pk2(r[4], r[5]); w.w = pk2(r[6], r[7]);
                        *(u32x4*)(ob + row * 4096 + col) = w;
                    } else if constexpr (MODE == 2 || MODE == 3) {
                        const u32x4 g = *(const u32x4*)(aux + row * 4096 + (MODE == 3 ? 2048 : 0) + col);
                        float r[8] = {v0[0], v0[1], v0[2], v0[3], v1[0], v1[1], v1[2], v1[3]};
                        const unsigned gw[4] = {g.x, g.y, g.z, g.w};
#pragma unroll
                        for (int i = 0; i < 4; ++i) { r[2 * i] *= bf2f(gw[i] & 0xffffu); r[2 * i + 1] *= __builtin_bit_cast(float, gw[i] & 0xffff0000u); }
                        if constexpr (MODE == 3) { const u32x4 pv = *(const u32x4*)(ob + row * 2048 + col); const unsigned pw[4] = {pv.x, pv.y, pv.z, pv.w};
#pragma unroll
                            for (int i = 0; i < 4; ++i) { r[2 * i] += bf2f(pw[i] & 0xffffu); r[2 * i + 1] += __builtin_bit_cast(float, pw[i] & 0xffff0000u); } }
                        u32x4 w; w.x = pk2(r[0], r[1]); w.y = pk2(r[2], r[3]); w.z = pk2(r[4], r[5]); w.w = pk2(r[6], r[7]);
                        *(u32x4*)(ob + row * 2048 + col) = w;
                    } else if constexpr (MODE == 4) {
                        const f32x4 g0 = *(const f32x4*)(vec + col), g1 = *(const f32x4*)(vec + col + 4);
                        const f32x4 x0 = *(const f32x4*)(xsrc + row * DM + col), x1 = *(const f32x4*)(xsrc + row * DM + col + 4);
                        *(f32x4*)(of + row * DM + col) = x0 + g0 * v0; *(f32x4*)(of + row * DM + col + 4) = x1 + g1 * v1;
                    } else if constexpr (MODE == 7) {
                        const f32x4 g0 = *(const f32x4*)(vec + col), g1 = *(const f32x4*)(vec + col + 4);
                        const f32x4 x0 = *(const f32x4*)(xsrc + row * DM + col), x1 = *(const f32x4*)(xsrc + row * DM + col + 4);
                        const f32x4 y0 = x0 + g0 * v0, y1 = x1 + g1 * v1;
                        *(f32x4*)(of + row * DM + col) = y0; *(f32x4*)(of + row * DM + col + 4) = y1;
                        ssq += (y0[0] * y0[0] + y0[1] * y0[1]) + (y0[2] * y0[2] + y0[3] * y0[3]) + (y1[0] * y1[0] + y1[1] * y1[1]) + (y1[2] * y1[2] + y1[3] * y1[3]);
                        const f32x4 s0 = *(const f32x4*)(vec2 + col) + 1.f, s1 = *(const f32x4*)(vec2 + col + 4) + 1.f;
                        const f32x4 a0 = y0 * s0, a1 = y1 * s1;
                        u32x4 w; w.x = pk2(a0[0], a0[1]); w.y = pk2(a0[2], a0[3]); w.z = pk2(a1[0], a1[1]); w.w = pk2(a1[2], a1[3]);
                        *(u32x4*)(ob + row * DM + col) = w;
                    } else if constexpr (MODE == 8) {
                        const f32x4 b0 = *(const f32x4*)(vec + col), b1 = *(const f32x4*)(vec + col + 4);
                        float r[8] = {v0[0] * rstd + b0[0], v0[1] * rstd + b0[1], v0[2] * rstd + b0[2], v0[3] * rstd + b0[3], v1[0] * rstd + b1[0], v1[1] * rstd + b1[1], v1[2] * rstd + b1[2], v1[3] * rstd + b1[3]};
#pragma unroll
                        for (int i = 0; i < 8; ++i) { const float q = fmaxf(r[i], 0.f); r[i] = q * q; }
                        u32x4 w; w.x = pk2(r[0], r[1]); w.y = pk2(r[2], r[3]); w.z = pk2(r[4], r[5]); w.w = pk2(r[6], r[7]);
                        *(u32x4*)(ob + row * HIDN + col) = w;
                    } else {
                        float r[8] = {v0[0], v0[1], v0[2], v0[3], v1[0], v1[1], v1[2], v1[3]};
#pragma unroll
                        for (int i = 0; i < 8; ++i) { const float q = fmaxf(r[i], 0.f); r[i] = q * q; }
                        u32x4 w; w.x = pk2(r[0], r[1]); w.y = pk2(r[2], r[3]); w.z = pk2(r[4], r[5]); w.w = pk2(r[6], r[7]);
                        *(u32x4*)(ob + row * HIDN + col) = w;
                    }
                }
                if constexpr (MODE == 7) {
                    ssq = swap16_sum(ssq, ssq); ssq = swap32_sum(ssq, ssq);
                    if (fq == 0) (void)__hip_atomic_fetch_add(rs + row, ssq, __ATOMIC_RELAXED, __HIP_MEMORY_SCOPE_AGENT);
                }
            }
    }
};

template <int MODE, bool F8 = false>
__device__ __forceinline__ void run_gemm(LAS unsigned char* lds, const void* A, const void* Bt, int N, int K, const Epi<MODE>& E, int rot = 0) {
    pg8::Gemm g{(const bf16_t*)A, (const bf16_t*)Bt, SEQ, N, K}; pg8::StaticOrder S; S.init(SEQ, N, (int)gridDim.x, (int)((blockIdx.x + rot) % gridDim.x));
    pg8::gemm_phase<Epi<MODE>, pg8::StaticOrder, true, true, F8>(lds, g, S, E);
}

template <bool F8>
__device__ __forceinline__ void transpose_item(const float* W, int ldw, int K, int N, int Npad, void* WTv, LAS float* scr, int item, int lane) {
    const int nblk = Npad / 32, kb = item / nblk, nb = item % nblk, k0 = 64 * kb, n0 = 32 * nb;
    const int c4 = (lane & 7) * 4; const bool ok = (n0 + c4) < N;
    f32x4 tv[8];
#pragma unroll
    for (int i = 0; i < 8; ++i) { const int kk = 8 * i + (lane >> 3); tv[i] = ok ? *(const f32x4*)(W + (size_t)(k0 + kk) * ldw + n0 + c4) : (f32x4){0.f, 0.f, 0.f, 0.f}; }
#pragma unroll
    for (int i = 0; i < 8; ++i) { const int kk = 8 * i + (lane >> 3); LAS float* d = scr + kk * 33 + c4; d[0] = tv[i][0]; d[1] = tv[i][1]; d[2] = tv[i][2]; d[3] = tv[i][3]; }
    asm volatile("s_waitcnt lgkmcnt(0)" ::: "memory");
    const int c = lane & 7;
#pragma unroll
    for (int j = 0; j < 4; ++j) { const int n = (lane >> 3) + 8 * j; const LAS float* s = scr + (8 * c) * 33 + n;
        if constexpr (F8) { const float x[8] = {s[0] * W8_SCALE, s[33] * W8_SCALE, s[66] * W8_SCALE, s[99] * W8_SCALE, s[132] * W8_SCALE, s[165] * W8_SCALE, s[198] * W8_SCALE, s[231] * W8_SCALE};
            *(u32x2*)((unsigned char*)WTv + (size_t)(n0 + n) * K + k0 + 8 * c) = to_fp8x8(x); }
        else { u32x4 o; o.x = pk2(s[0 * 33], s[1 * 33]); o.y = pk2(s[2 * 33], s[3 * 33]); o.z = pk2(s[4 * 33], s[5 * 33]); o.w = pk2(s[6 * 33], s[7 * 33]);
            *(u32x4*)((bf16_t*)WTv + (size_t)(n0 + n) * K + k0 + 8 * c) = o; } }
    asm volatile("s_waitcnt lgkmcnt(0)" ::: "memory");
}

__device__ __forceinline__ void mod_item(const float* c, const float* w_ada, const float* b_ada, float* mod, LAS float* red, int it, int tid) {
    const int l = it / 384, n0 = (it % 384) * 32, cl = tid & 7, kg = tid >> 3;
    const float* W = w_ada + (size_t)l * DM * NMOD + n0 + 4 * cl;
    f32x4 a0 = {0.f, 0.f, 0.f, 0.f}, a1 = {0.f, 0.f, 0.f, 0.f};
#pragma unroll 16
    for (int k = kg * 32; k < kg * 32 + 32; ++k) {
        const f32x4 w = *(const f32x4*)(W + (size_t)k * NMOD); float c0 = c[k], c1 = c[DM + k];
        c0 = c0 / (1.f + __expf(-c0)); c1 = c1 / (1.f + __expf(-c1)); a0 += w * c0; a1 += w * c1; }
#pragma unroll
    for (int e = 0; e < 4; ++e) { red[(kg * 2 + 0) * 32 + 4 * cl + e] = a0[e]; red[(kg * 2 + 1) * 32 + 4 * cl + e] = a1[e]; }
    __syncthreads();
    if (tid < 64) { const int b = tid >> 5, col = tid & 31; float s = 0.f;
#pragma unroll 16
        for (int g = 0; g < 64; ++g) s += red[(g * 2 + b) * 32 + col];
        mod[((size_t)l * 2 + b) * NMOD + n0 + col] = s + b_ada[(size_t)l * NMOD + n0 + col]; }
    __syncthreads();
}

template <bool F8>
__device__ __forceinline__ void norm_row(const float* xrow, const float* sh, const float* sc, bf16_t* hrow, unsigned char* h8row, int lane) {
    f32x4 v[8]; float ss = 0.f;
#pragma unroll
    for (int j = 0; j < 8; ++j) { v[j] = ((const f32x4*)xrow)[lane + 64 * j]; ss += (v[j].x * v[j].x + v[j].y * v[j].y) + (v[j].z * v[j].z + v[j].w * v[j].w); }
    ss = wave_sum(ss); const float r = 1.f / sqrtf(ss * (1.f / DM) + EPS);
#pragma unroll
    for (int j = 0; j < 8; ++j) { const f32x4 s4 = ((const f32x4*)sc)[lane + 64 * j], h4 = ((const f32x4*)sh)[lane + 64 * j];
        const f32x4 y = v[j] * r * (s4 + 1.f) + h4; u32x2 o; o.x = pk2(y.x, y.y); o.y = pk2(y.z, y.w); ((u32x2*)hrow)[lane + 64 * j] = o;
        if constexpr (F8) { int t0 = __builtin_amdgcn_cvt_pk_fp8_f32(y.x, y.y, 0, false); t0 = __builtin_amdgcn_cvt_pk_fp8_f32(y.z, y.w, t0, true); ((unsigned*)h8row)[lane + 64 * j] = (unsigned)t0; } }
}

__device__ __forceinline__ float row16_sum(float v) { v += dpp_f<0x128>(v); v += dpp_f<0x124>(v); v += dpp_f<0x4E>(v); v += dpp_f<0xB1>(v); return v; }
template <int NIT, bool F8>
__device__ __forceinline__ void post_segment(bf16_t* seg, const float* gain, const float (&cs)[8], const float (&sn)[8], int c, int grp, unsigned char* k8 = nullptr) {
    const f32x4 g0 = *(const f32x4*)(gain + 8 * c), g1 = *(const f32x4*)(gain + 8 * c + 4);
    const float g[8] = {g0[0], g0[1], g0[2], g0[3], g1[0], g1[1], g1[2], g1[3]};
    u32x4 raw[NIT];
#pragma unroll
    for (int it = 0; it < NIT; ++it) raw[it] = *(const u32x4*)(seg + (it * 4 + grp) * 128 + c * 8);
#pragma unroll
    for (int it = 0; it < NIT; ++it) {
        const unsigned w[4] = {raw[it].x, raw[it].y, raw[it].z, raw[it].w}; float x[8];
#pragma unroll
        for (int i = 0; i < 4; ++i) { x[2 * i] = bf2f(w[i] & 0xffffu); x[2 * i + 1] = __builtin_bit_cast(float, w[i] & 0xffff0000u); }
        float ss = 0.f;
#pragma unroll
        for (int e = 0; e < 8; ++e) ss += x[e] * x[e];
        ss = row16_sum(ss); const float r = 1.f / sqrtf(ss * (1.f / 128.f) + EPS);
        float o[8];
#pragma unroll
        for (int e = 0; e < 8; ++e) { const float y = x[e] * r * g[e]; const float py = dpp_f<0x128>(y); o[e] = y * cs[e] + py * sn[e]; }
        u32x4 ow; ow.x = pk2(o[0], o[1]); ow.y = pk2(o[2], o[3]); ow.z = pk2(o[4], o[5]); ow.w = pk2(o[6], o[7]);
        if constexpr (F8) *(u32x2*)(k8 + (it * 4 + grp) * 128 + c * 8) = to_fp8x8(o);
        else *(u32x4*)(seg + (it * 4 + grp) * 128 + c * 8) = ow;
    }
}
__device__ __forceinline__ void post_token(int pos, const float* gaq, const float* gak, const float* gbq, const float* gbk, const float* gik,
                                           bf16_t* qrow, const float* irow, bf16_t* iq, bf16_t* ik, float* iw, unsigned char* k8, unsigned char* v8, int lane) {
    const float pf = (float)pos; const int c = lane & 15, grp = lane >> 4; const float sgn = (c < 8) ? -1.f : 1.f;
    float cs[8], sn[8];
#pragma unroll
    for (int e = 0; e < 8; ++e) { float s_; rope_cs(pf * INVF[8 * (c & 7) + e], cs[e], s_); sn[e] = s_ * sgn; }
    post_segment<3, false>(qrow + COL_AQ, gaq, cs, sn, c, grp);
    post_segment<3, false>(qrow + COL_AK, gak, cs, sn, c, grp);
    post_segment<2, false>(qrow + COL_BQ, gbq, cs, sn, c, grp);
    post_segment<2, true>(qrow + COL_BK, gbk, cs, sn, c, grp, k8);
    float ci[4], si[4];
#pragma unroll
    for (int e = 0; e < 4; ++e) { float s_; rope_cs(pf * INVF[2 * ((4 * c + e) & 31)], ci[e], s_); si[e] = s_ * sgn; }
    f32x4 xi[4];
#pragma unroll
    for (int it = 0; it < 4; ++it) xi[it] = *(const f32x4*)(irow + (it * 4 + grp) * 64 + 4 * c);
    const f32x4 xk = *(const f32x4*)(irow + 1024 + 4 * c);
#pragma unroll
    for (int it = 0; it < 4; ++it) { float o[4];
#pragma unroll
        for (int e = 0; e < 4; ++e) { const float x = xi[it][e]; const float px = dpp_f<0x128>(x); o[e] = x * ci[e] + px * si[e]; }
        u32x2 ow; ow.x = pk2(o[0], o[1]); ow.y = pk2(o[2], o[3]); *(u32x2*)(iq + (it * 4 + grp) * 64 + 4 * c) = ow; }
    { const f32x4 gk = *(const f32x4*)(gik + 4 * c);
      float ss = (xk[0] * xk[0] + xk[1] * xk[1]) + (xk[2] * xk[2] + xk[3] * xk[3]); ss = row16_sum(ss); const float r = 1.f / sqrtf(ss * (1.f / 64.f) + EPS);
      float o[4];
#pragma unroll
      for (int e = 0; e < 4; ++e) { const float y = xk[e] * r * gk[e]; const float py = dpp_f<0x128>(y); o[e] = y * ci[e] + py * si[e]; }
      if (grp == 0) { u32x2 ow; ow.x = pk2(o[0], o[1]); ow.y = pk2(o[2], o[3]); *(u32x2*)(ik + 4 * c) = ow; } }
    if (lane < 16) iw[lane] = irow[1088 + lane] * 0.25f;
}

typedef float f32x2_t __attribute__((ext_vector_type(2)));
__device__ __forceinline__ void s8_issue_k(long (&kf)[16], const unsigned char* K8h, LAS const int* wsel, int j0, int n16, int slab) {
#pragma unroll
    for (int g = 0; g < 4; ++g) { const unsigned char* kp = K8h + (size_t)wsel[j0 + 16 * g + n16] * 1024 + 16 * slab;
        const u32x4 lo = *(const u32x4*)kp, hi = *(const u32x4*)(kp + 64);
        kf[g * 4 + 0] = (long)(((unsigned long long)lo.y << 32) | lo.x); kf[g * 4 + 1] = (long)(((unsigned long long)lo.w << 32) | lo.z);
        kf[g * 4 + 2] = (long)(((unsigned long long)hi.y << 32) | hi.x); kf[g * 4 + 3] = (long)(((unsigned long long)hi.w << 32) | hi.z); }
}
template <int Q> __device__ __forceinline__ void s9_issue_v(unsigned (&vv)[8], const unsigned char* V8h, LAS const unsigned* otw, int half, int l4) {
#pragma unroll
    for (int u2 = 0; u2 < 8; ++u2) vv[u2] = *(const unsigned*)(V8h + (otw[2 * (Q * 8 + u2) + half] | (unsigned)l4));
}
template <int Q> __device__ __forceinline__ void s9_pv(const unsigned (&vv)[8], LAS const float* ptw, int half, f32x2_t& oa, f32x2_t& ob) {
#pragma unroll
    for (int u2 = 0; u2 < 8; ++u2) { const float p = ptw[2 * (Q * 8 + u2) + half];
        oa = __builtin_amdgcn_cvt_pk_f32_fp8((int)vv[u2], false) * p + oa; ob = __builtin_amdgcn_cvt_pk_f32_fp8((int)vv[u2], true) * p + ob; }
}
__device__ __forceinline__ void sparse_unit7(const bf16_t* QKV, const unsigned char* K8, const unsigned char* V8, const int (&selv)[4], bf16_t* OB, LAS unsigned char* wl, int t, int h, int lane) {
    LAS int* wsel = (LAS int*)wl; LAS unsigned* otw = (LAS unsigned*)(wl + 1024); LAS float* ptw = (LAS float*)(wl + 2048);
    const int n16 = lane & 15, slab = lane >> 4, half = lane >> 5, l4 = (lane & 31) * 4;
    const bf16_t* qrow = QKV + (size_t)t * QKVW + COL_BQ + h * 128 + 16 * slab;
    long qa[4];
#pragma unroll
    for (int ks = 0; ks < 4; ++ks) { const u32x4 raw = *(const u32x4*)(qrow + 8 * (ks & 1) + 64 * (ks >> 1)); const unsigned w[4] = {raw.x, raw.y, raw.z, raw.w}; float x[8];
#pragma unroll
        for (int i = 0; i < 4; ++i) { x[2 * i] = bf2f(w[i] & 0xffffu); x[2 * i + 1] = __builtin_bit_cast(float, w[i] & 0xffff0000u); }
        const u32x2 f = to_fp8x8(x); qa[ks] = (long)(((unsigned long long)f.y << 32) | f.x); }
    const unsigned char* K8h = K8 + h * 128; const unsigned char* V8h = V8 + h * 128;
    const int n = min(256, t + 1), ns = (n + 63) >> 6;
#pragma unroll
    for (int s = 0; s < 4; ++s) { const int j = 64 * s + lane; const int id = (j < n) ? selv[s] : 0; wsel[j] = id; otw[j] = (unsigned)id * 1024u; }
    asm volatile("" ::: "memory");
    long kf[16]; unsigned va[8], vb[8];
    s8_issue_k(kf, K8h, wsel, 0, n16, slab);
    s9_issue_v<0>(va, V8h, otw, half, l4);
    float m = -INFINITY, l = 0.f; f32x2_t oa = {0.f, 0.f}, ob = {0.f, 0.f};
#pragma unroll
    for (int s = 0; s < 4; ++s) {
        if (s < ns) {
            const bool valid = (64 * s + lane) < n;
            LAS const unsigned* ot = otw + 64 * s; LAS float* pt = ptw + 64 * s;
            s9_issue_v<1>(vb, V8h, ot, half, l4);
            f32x4 acc[4];
#pragma unroll
            for (int g = 0; g < 4; ++g) { acc[g] = (f32x4){0.f, 0.f, 0.f, 0.f};
#pragma unroll
                for (int ks = 0; ks < 4; ++ks) acc[g] = __builtin_amdgcn_mfma_f32_16x16x32_fp8_fp8(qa[ks], kf[g * 4 + ks], acc[g], 0, 0, 0); }
            float sc = (slab == 0) ? acc[0][0] : (slab == 1) ? acc[1][0] : (slab == 2) ? acc[2][0] : acc[3][0];
            sc = valid ? sc * 0.08838834764831845f : -INFINITY;
            const float mn = fmaxf(m, wave_max(sc));
            const float alpha = __expf(m - mn), p = __expf(sc - mn);
            oa = oa * alpha; ob = ob * alpha; m = mn; l = l * alpha + p;
            pt[lane] = p;
            asm volatile("" ::: "memory");
            const int sn_ = (s < 3) ? (s + 1) : 3;
            s8_issue_k(kf, K8h, wsel, 64 * sn_, n16, slab);
            s9_pv<0>(va, pt, half, oa, ob);
            s9_issue_v<2>(va, V8h, ot, half, l4);
            s9_pv<1>(vb, pt, half, oa, ob);
            s9_issue_v<3>(vb, V8h, ot, half, l4);
            s9_pv<2>(va, pt, half, oa, ob);
            s9_issue_v<0>(va, V8h, otw + 64 * sn_, half, l4);
            s9_pv<3>(vb, pt, half, oa, ob);
        }
    }
    const float inv = 1.f / wave_sum(l);
    const float r0 = swap32_sum(oa.x, oa.x), r1 = swap32_sum(oa.y, oa.y), r2 = swap32_sum(ob.x, ob.x), r3 = swap32_sum(ob.y, ob.y);
    if (half == 0) { u32x2 o; o.x = pk2(r0 * inv, r1 * inv); o.y = pk2(r2 * inv, r3 * inv); *(u32x2*)(OB + (size_t)t * 1024 + h * 128 + l4) = o; }
    asm volatile("" ::: "memory");
}

typedef short v4i16_t __attribute__((ext_vector_type(4)));
constexpr int VRS = 272;
__device__ __forceinline__ void dilated_block(const bf16_t* QKV, bf16_t* OG, float* LSE, LAS unsigned char* lds, int u, int tid) {
    const int lane = tid & 63, wave = __builtin_amdgcn_readfirstlane(tid >> 6), n16 = lane & 15, slab = lane >> 4;
    const int g = u >> 9, rem = u & 511, hs = rem >> 7, pn = rem & 127;
    const int rsh = 2 * g, nbk = 128 >> rsh, p = pn >> (7 - rsh), nb = pn & (nbk - 1);
    const int head = g * 4 + hs, mbase = 128 * (nb - 1);
    __syncthreads();
#pragma unroll
    for (int i = 0; i < 8; ++i) { const int c = tid + 512 * i, row = c >> 4, ch = c & 15, m = mbase + row; u32x4 v = {0u, 0u, 0u, 0u};
        if (m >= 0) v = *(const u32x4*)(QKV + (size_t)((m << rsh) + p) * QKVW + COL_AV + head * 128 + ch * 8);
        *(LAS u32x4*)(lds + row * VRS + ch * 16) = v; }
    __syncthreads();
    const int i0 = wave * 16;
    const int tq = ((mbase + 128 + i0 + n16) << rsh) + p;
    bf16x8 qf[4];
#pragma unroll
    for (int ks = 0; ks < 4; ++ks) qf[ks] = *(const bf16x8*)(QKV + (size_t)tq * QKVW + COL_AQ + head * 128 + ks * 32 + slab * 8);
    f32x4 sacc[10];
#pragma unroll
    for (int jt = 0; jt < 9; ++jt) { int m = mbase + i0 + 16 * jt + n16; m = max(m, 0);
        const bf16_t* kp = QKV + (size_t)((m << rsh) + p) * QKVW + COL_AK + head * 128 + slab * 8;
        f32x4 acc = {0.f, 0.f, 0.f, 0.f};
#pragma unroll
        for (int ks = 0; ks < 4; ++ks) acc = __builtin_amdgcn_mfma_f32_16x16x32_bf16(*(const bf16x8*)(kp + ks * 32), qf[ks], acc, 0, 0, 0);
        sacc[jt] = acc; }
    float mx = -INFINITY;
#pragma unroll
    for (int jt = 0; jt < 9; ++jt)
#pragma unroll
        for (int i = 0; i < 4; ++i) { const int d = 128 + n16 - 16 * jt - 4 * slab - i, kk = i0 + 16 * jt + 4 * slab + i;
            const bool ok = (d >= 0) && (d <= 128) && (nb > 0 || kk >= 128);
            const float s = ok ? sacc[jt][i] * 0.08838834764831845f : -INFINITY; sacc[jt][i] = s; mx = fmaxf(mx, s); }
    { unsigned x, y; pl16(__builtin_bit_cast(unsigned, mx), __builtin_bit_cast(unsigned, mx), x, y); mx = fmaxf(__builtin_bit_cast(float, x), __builtin_bit_cast(float, y));
      pl32(__builtin_bit_cast(unsigned, mx), __builtin_bit_cast(unsigned, mx), x, y); mx = fmaxf(__builtin_bit_cast(float, x), __builtin_bit_cast(float, y)); }
    float lsum = 0.f;
#pragma unroll
    for (int jt = 0; jt < 9; ++jt)
#pragma unroll
        for (int i = 0; i < 4; ++i) { const float pe = __expf(sacc[jt][i] - mx); sacc[jt][i] = pe; lsum += pe; }
    sacc[9] = (f32x4){0.f, 0.f, 0.f, 0.f};
    lsum = swap16_sum(lsum, lsum); lsum = swap32_sum(lsum, lsum);
    if (slab == 0) LSE[(size_t)tq * 12 + head] = mx + __logf(lsum);
    f32x4 oacc[8];
#pragma unroll
    for (int c = 0; c < 8; ++c) oacc[c] = (f32x4){0.f, 0.f, 0.f, 0.f};
    const int q4 = n16 >> 2, p4 = lane & 3;
#pragma unroll
    for (int u2 = 0; u2 < 5; ++u2) {
        u32x4 pw; pw.x = pk2(sacc[2 * u2][0], sacc[2 * u2][1]); pw.y = pk2(sacc[2 * u2][2], sacc[2 * u2][3]); pw.z = pk2(sacc[2 * u2 + 1][0], sacc[2 * u2 + 1][1]); pw.w = pk2(sacc[2 * u2 + 1][2], sacc[2 * u2 + 1][3]);
        const bf16x8 pf = __builtin_bit_cast(bf16x8, pw);
        const int r0 = min(i0 + 32 * u2 + 4 * slab + q4, 255), r1 = min(i0 + 32 * u2 + 16 + 4 * slab + q4, 255);
        LAS unsigned char* a0p = lds + r0 * VRS + 8 * p4; LAS unsigned char* a1p = lds + r1 * VRS + 8 * p4;
#pragma unroll
        for (int c = 0; c < 8; ++c) {
            const v4i16_t lo = __builtin_amdgcn_ds_read_tr16_b64_v4i16((LAS v4i16_t*)(a0p + c * 32)), hi = __builtin_amdgcn_ds_read_tr16_b64_v4i16((LAS v4i16_t*)(a1p + c * 32));
            const bf16x8 vf = __builtin_shufflevector(lo, hi, 0, 1, 2, 3, 4, 5, 6, 7);
            oacc[c] = __builtin_amdgcn_mfma_f32_16x16x32_bf16(vf, pf, oacc[c], 0, 0, 0);
        }
    }
    const float inv = 1.f / lsum;
    bf16_t* op = OG + ((size_t)g * SEQ + tq) * 512 + hs * 128 + 4 * slab;
#pragma unroll
    for (int c = 0; c < 8; ++c) { u32x2 o; o.x = pk2(oacc[c][0] * inv, oacc[c][1] * inv); o.y = pk2(oacc[c][2] * inv, oacc[c][3] * inv); *(u32x2*)(op + 16 * c) = o; }
}
__device__ __forceinline__ void dilated_merge(const bf16_t* OG, const float* LSE, bf16_t* OA, int t, int hs, int lane) {
    const float l0 = LSE[(size_t)t * 12 + hs], l1 = LSE[(size_t)t * 12 + 4 + hs], l2 = LSE[(size_t)t * 12 + 8 + hs];
    const float mx = fmaxf(l0, fmaxf(l1, l2)); float w0 = __expf(l0 - mx), w1 = __expf(l1 - mx), w2 = __expf(l2 - mx);
    const float inv = 1.f / (w0 + w1 + w2); w0 *= inv; w1 *= inv; w2 *= inv;
    const size_t off = (size_t)t * 512 + hs * 128 + 2 * lane;
    const unsigned v0 = *(const unsigned*)(OG + off), v1 = *(const unsigned*)(OG + (size_t)SEQ * 512 + off), v2 = *(const unsigned*)(OG + (size_t)2 * SEQ * 512 + off);
    const float o0 = w0 * bf2f(v0 & 0xffffu) + w1 * bf2f(v1 & 0xffffu) + w2 * bf2f(v2 & 0xffffu);
    const float o1 = w0 * __builtin_bit_cast(float, v0 & 0xffff0000u) + w1 * __builtin_bit_cast(float, v1 & 0xffff0000u) + w2 * __builtin_bit_cast(float, v2 & 0xffff0000u);
    *(unsigned*)(OA + off) = pk2(o0, o1);
}

constexpr int ICAP = 512, NQI = 4;
__device__ __forceinline__ unsigned f2sort(float f) { const unsigned b = __builtin_bit_cast(unsigned, f); return b ^ ((b & 0x80000000u) ? 0xffffffffu : 0x80000000u); }
__device__ __forceinline__ float sort2f(unsigned u) { return __builtin_bit_cast(float, u ^ ((u & 0x80000000u) ? 0x80000000u : 0xffffffffu)); }
__device__ __forceinline__ void idx_compact(LAS float* bs, LAS unsigned* bi, int& cnt, float& tau, int lane) {
    unsigned u[ICAP / 64], id[ICAP / 64];
#pragma unroll
    for (int i = 0; i < ICAP / 64; ++i) { const int e = i * 64 + lane; const bool in = e < cnt; u[i] = in ? f2sort(bs[e]) : 0u; id[i] = in ? bi[e] : 0u; }
    unsigned T = 0u;
#pragma unroll 1
    for (int bit = 31; bit >= 0; --bit) { const unsigned cand = T | (1u << bit); int c = 0;
#pragma unroll
        for (int i = 0; i < ICAP / 64; ++i) c += __popcll(__ballot(u[i] >= cand));
        if (c >= 256) T = cand; if (c == 256) break; }
    int ngt = 0;
#pragma unroll
    for (int i = 0; i < ICAP / 64; ++i) ngt += __popcll(__ballot(u[i] > T));
    const int need_eq = 256 - ngt;
    int base = 0, eqbase = 0;
    __builtin_amdgcn_wave_barrier();
#pragma unroll
    for (int i = 0; i < ICAP / 64; ++i) {
        const bool gt = u[i] > T, eq = u[i] == T;
        const unsigned long long em = __ballot(eq); const int eqpos = eqbase + lane_prefix(em); eqbase += __popcll(em);
        const bool keep = gt || (eq && eqpos < need_eq);
        const unsigned long long km = __ballot(keep); const int pos = base + lane_prefix(km); base += __popcll(km);
        if (keep) { bs[pos] = sort2f(u[i]); bi[pos] = id[i]; }
    }
    __builtin_amdgcn_wave_barrier();
    cnt = 256; tau = sort2f(T);
}
__device__ __forceinline__ void idx_load(bf16x8 (&f)[8], const bf16_t* IK, int kb, int n16, int slab) {
#pragma unroll
    for (int g = 0; g < 4; ++g) { const bf16_t* kp = IK + (size_t)(kb * 64 + g * 16 + n16) * 64 + slab * 8; f[2 * g] = *(const bf16x8*)kp; f[2 * g + 1] = *(const bf16x8*)(kp + 32); }
}
__device__ __forceinline__ void idx_wait8(bf16x8 (&)[8]) {}
__device__ __forceinline__ void idx_wait0(bf16x8 (&)[8], bf16x8 (&)[8]) {}
typedef _Float16 h2_t __attribute__((ext_vector_type(2)));
typedef _Float16 h4_t __attribute__((ext_vector_type(4)));
__device__ __forceinline__ float idx_score(const bf16x8 (&f)[8], const bf16x8 a0, const bf16x8 a1, const h4_t (&wa)[4]) {
    f32x4 s = {0.f, 0.f, 0.f, 0.f}; const h2_t z = {(_Float16)0, (_Float16)0};
#pragma unroll
    for (int g = 0; g < 4; ++g) {
        f32x4 acc = {0.f, 0.f, 0.f, 0.f};
        acc = __builtin_amdgcn_mfma_f32_16x16x32_bf16(a0, f[2 * g], acc, 0, 0, 0);
        acc = __builtin_amdgcn_mfma_f32_16x16x32_bf16(a1, f[2 * g + 1], acc, 0, 0, 0);
        h2_t lo = {(_Float16)acc[0], (_Float16)acc[1]}, hi = {(_Float16)acc[2], (_Float16)acc[3]};
        lo = __builtin_elementwise_max(lo, z); hi = __builtin_elementwise_max(hi, z);
        const h4_t bb = {lo[0], lo[1], hi[0], hi[1]};
        s = __builtin_amdgcn_mfma_f32_16x16x16f16(wa[g], bb, s, 0, 0, 0);
    }
    return s[0];
}
__device__ __forceinline__ void idx_append(float score, LAS float* bs, LAS unsigned* bi, int& cnt, float& tau, int kb, int t, int lane) {
    const int kidx = kb * 64 + lane;
    const bool valid = (kidx <= t) && (score > tau);
    const unsigned long long vm = __ballot(valid); const int pos = cnt + lane_prefix(vm);
    if (valid) { bs[pos] = score; bi[pos] = (unsigned)kidx; }
    cnt += __popcll(vm);
    __builtin_amdgcn_wave_barrier();
    if (cnt > ICAP - 64) idx_compact(bs, bi, cnt, tau, lane);
}
__device__ __forceinline__ void indexer_unit(const bf16_t* IQ, const bf16_t* IK, const float* IW, unsigned short* SEL, LAS unsigned char* wlds, int t0, int lane) {
    const int n16 = lane & 15, slab = lane >> 4;
    bf16x8 a0[NQI], a1[NQI]; h4_t wa[NQI][4]; int cnt[NQI]; float tau[NQI];
#pragma unroll
    for (int q = 0; q < NQI; ++q) { const size_t t = (size_t)(t0 + q);
        a0[q] = *(const bf16x8*)(IQ + t * 1024 + n16 * 64 + slab * 8); a1[q] = *(const bf16x8*)(IQ + t * 1024 + n16 * 64 + 32 + slab * 8);
        const f32x4 wv = *(const f32x4*)(IW + t * 16 + slab * 4); const h4_t wh = {(_Float16)wv[0], (_Float16)wv[1], (_Float16)wv[2], (_Float16)wv[3]};
        const h4_t hz = {(_Float16)0, (_Float16)0, (_Float16)0, (_Float16)0};
#pragma unroll
        for (int g = 0; g < 4; ++g) wa[q][g] = (n16 == 4 * g) ? wh : hz;
        cnt[q] = 0; tau[q] = -INFINITY; }
    const int nkb = t0 / 64 + 1;
#pragma unroll
    for (int q = 0; q < NQI; ++q) asm volatile("" :: "v"(a0[q]), "v"(a1[q]), "v"(wa[q][0]), "v"(wa[q][1]), "v"(wa[q][2]), "v"(wa[q][3]));
    bf16x8 fa[8], fb[8];
#pragma unroll
    for (int i = 0; i < 8; ++i) { fa[i] = (bf16x8){0, 0, 0, 0, 0, 0, 0, 0}; fb[i] = fa[i]; }
    idx_load(fa, IK, 0, n16, slab);
#pragma unroll 1
    for (int kb = 0; kb < nkb; kb += 2) {
        idx_load(fb, IK, min(kb + 1, nkb - 1), n16, slab);
        idx_wait8(fa);
        { float sc[NQI];
#pragma unroll
          for (int q = 0; q < NQI; ++q) sc[q] = idx_score(fa, a0[q], a1[q], wa[q]);
#pragma unroll
          for (int q = 0; q < NQI; ++q) idx_append(sc[q], (LAS float*)(wlds + q * 4096), (LAS unsigned*)(wlds + q * 4096 + 2048), cnt[q], tau[q], kb, t0 + q, lane); }
        idx_load(fa, IK, min(kb + 2, nkb - 1), n16, slab);
        idx_wait8(fb);
        if (kb + 1 < nkb) {
            float sc[NQI];
#pragma unroll
            for (int q = 0; q < NQI; ++q) sc[q] = idx_score(fb, a0[q], a1[q], wa[q]);
#pragma unroll
            for (int q = 0; q < NQI; ++q) idx_append(sc[q], (LAS float*)(wlds + q * 4096), (LAS unsigned*)(wlds + q * 4096 + 2048), cnt[q], tau[q], kb + 1, t0 + q, lane);
        }
    }
    idx_wait0(fa, fb);
#pragma unroll
    for (int q = 0; q < NQI; ++q) {
        LAS float* bs = (LAS float*)(wlds + q * 4096); LAS unsigned* bi = (LAS unsigned*)(wlds + q * 4096 + 2048);
        if (cnt[q] > 256) idx_compact(bs, bi, cnt[q], tau[q], lane);
        __builtin_amdgcn_wave_barrier();
        unsigned short* sel = SEL + (size_t)(t0 + q) * 256;
#pragma unroll
        for (int j = 0; j < 4; ++j) { const int e = j * 64 + lane; if (e < cnt[q]) sel[e] = (unsigned short)bi[e]; }
    }
    __builtin_amdgcn_wave_barrier();
}

#define RLX_AGENT __ATOMIC_RELAXED, __HIP_MEMORY_SCOPE_AGENT
#define XB_TMO      128
#define XB_XCNT(j)  (256  + 64 * (j))
#define XB_XSUB(j)  (1280 + 64 * (j))
#define XB_XGEN(j)  (2304 + 64 * (j))
#define XB_TOP      3328
#define XB_TOPGEN   3392
#define XCD_BAR_WORDS 3456
#define XB_SPIN_CAP (1u << 18)

__device__ __forceinline__ unsigned xb_ld(unsigned* p)              { return __hip_atomic_load(p, __ATOMIC_RELAXED, __HIP_MEMORY_SCOPE_AGENT); }
__device__ __forceinline__ unsigned xb_add(unsigned* p, unsigned v) { return __hip_atomic_fetch_add(p, v, __ATOMIC_RELAXED, __HIP_MEMORY_SCOPE_AGENT); }
__device__ __forceinline__ unsigned xb_xcc_id() { return (unsigned)__builtin_amdgcn_s_getreg((3 << 11) | 20) & 0xFu; }
#define XB_SPIN(cond, bar) do { unsigned _sp = 0; while (cond) { __builtin_amdgcn_s_sleep(1); \
    if ((++_sp & 255u) == 0u) { if (xb_ld(&(bar)[XB_TMO])) break; if (_sp > XB_SPIN_CAP) { atomicAdd(&(bar)[XB_TMO], 1u); break; } } } } while (0)

struct XcdBarrier {
    unsigned* bar; unsigned x;
    volatile LAS unsigned* st;
};

__device__ __forceinline__ XcdBarrier xcd_barrier_post(unsigned* bar, volatile LAS unsigned* st) {
    XcdBarrier b; b.bar = bar; b.x = xb_xcc_id(); b.st = st;
    if (threadIdx.x == 0) (void)xb_add(&bar[XB_XCNT(b.x)], 1u);
    return b;
}
__device__ __forceinline__ void xcd_barrier_complete(unsigned* bar, unsigned x, unsigned& nloc, unsigned& nx) {
    const unsigned G = gridDim.x * gridDim.y * gridDim.z;
    unsigned sum, cnt, mine, sp = 0u;
    for (;;) {
        sum = 0u; cnt = 0u; mine = 0u;
#pragma unroll
        for (unsigned j = 0; j < 16; ++j) { const unsigned c = xb_ld(&bar[XB_XCNT(j)]); sum += c; cnt += (c > 0u) ? 1u : 0u; mine = (j == x) ? c : mine; }
        if (sum == G) break;
        __builtin_amdgcn_s_sleep(1);
        if ((++sp & 255u) == 0u) { if (xb_ld(&bar[XB_TMO])) break; if (sp > XB_SPIN_CAP) { atomicAdd(&bar[XB_TMO], 1u); break; } }
    }
    nloc = mine > 0u ? mine : 1u; nx = cnt > 0u ? cnt : 1u;
}

__device__ __forceinline__ void xcd_barrier(const XcdBarrier& b) {
    asm volatile("s_waitcnt vmcnt(0)" ::: "memory");
    __syncthreads();
    if (threadIdx.x == 0) {
        unsigned* bar = b.bar;
        __builtin_amdgcn_s_waitcnt(0);
        unsigned nloc = b.st[0], nx = b.st[1];
        if (nloc == 0u) { xcd_barrier_complete(bar, b.x, nloc, nx); b.st[0] = nloc; b.st[1] = nx; }
        const unsigned old = xb_add(&bar[XB_XSUB(b.x)], 1u);
        const unsigned gen = old / nloc;
        if (old + 1u == (gen + 1u) * nloc) {
            __builtin_amdgcn_fence(__ATOMIC_RELEASE, "agent");
            asm volatile("s_waitcnt vmcnt(0)" ::: "memory");
            const unsigned og = xb_add(&bar[XB_TOP], 1u);
            const unsigned tg = og / nx;
            if (og + 1u == (tg + 1u) * nx) xb_add(&bar[XB_TOPGEN], 1u);
            else XB_SPIN(xb_ld(&bar[XB_TOPGEN]) == tg, bar);
            __builtin_amdgcn_fence(__ATOMIC_ACQUIRE, "agent");
            xb_add(&bar[XB_XGEN(b.x)], 1u);
            asm volatile("s_waitcnt vmcnt(0)" ::: "memory");
        } else {
            XB_SPIN(xb_ld(&bar[XB_XGEN(b.x)]) == gen, bar);
            __builtin_amdgcn_fence(__ATOMIC_ACQUIRE, "agent");
            asm volatile("s_waitcnt vmcnt(0)" ::: "memory");
        }
    }
    __syncthreads();
}

#ifndef REP_IDX
#define REP_IDX 1
#endif
#ifndef REP_DIL
#define REP_DIL 1
#endif
#ifndef REP_SP
#define REP_SP 1
#endif
#ifndef REP_POST
#define REP_POST 1
#endif
#ifndef REP_PREP
#define REP_PREP 1
#endif
#ifndef REP_P
#define REP_P 1
#endif
#ifndef REP_N
#define REP_N 1
#endif
#ifndef REP_G
#define REP_G 1
#endif
#ifndef PHMASK
#define PHMASK 0xFFFF
#endif
#define PHON(k) ((PHMASK >> (k)) & 1)
struct Args { const float* in[18]; float* out; unsigned char* ws; int ph_lo, ph_hi; };
enum { I_X = 0, I_C, I_POS, I_WADA, I_BADA, I_WIN, I_GAQ, I_GAK, I_GBQ, I_GBK, I_GIK, I_WG, I_BG, I_WPA, I_WPB, I_WO, I_WUP, I_WDN };

__global__ void __launch_bounds__(NTHREADS, 2) mega(Args a) {
    extern __shared__ __attribute__((aligned(16))) unsigned char lds_raw[];
    LAS unsigned char* lds = (LAS unsigned char*)lds_raw;
    cg::grid_group grid = cg::this_grid();
    const int G = gridDim.x, NGW = G * NWAVES;
    unsigned char* ws = a.ws;
    float* mod = (float*)(ws + WS_MOD);
    bf16_t* H = (bf16_t*)(ws + WS_H); bf16_t* QKV = (bf16_t*)(ws + WS_QKV); float* IDXF = (float*)(ws + WS_IDXF); bf16_t* HID = (bf16_t*)(ws + WS_HID);
    bf16_t* IQ = (bf16_t*)(ws + WS_IQ); bf16_t* IK = (bf16_t*)(ws + WS_IK); float* IW = (float*)(ws + WS_IW); unsigned short* SEL = (unsigned short*)(ws + WS_SEL);
    bf16_t* OA = (bf16_t*)(ws + WS_OA); bf16_t* OB = (bf16_t*)(ws + WS_OB); bf16_t* GT = (bf16_t*)(ws + WS_G); bf16_t* MRG = (bf16_t*)(ws + WS_MRG); bf16_t* OG = (bf16_t*)(ws + WS_OG); float* LSE = (float*)(ws + WS_LSE); unsigned char* K8 = ws + WS_K8; unsigned char* V8 = ws + WS_V8; unsigned char* H8 = ws + WS_H8; float* RS = (float*)(ws + WS_RS); float* BVEC = (float*)(ws + WS_BVEC);

    { volatile LAS unsigned* st = (volatile LAS unsigned*)(lds + 131072 + 64);
      if (threadIdx.x < 2) st[threadIdx.x] = 0u;
      __syncthreads(); }
    const XcdBarrier xb = xcd_barrier_post((unsigned*)(ws + WS_BAR), (volatile LAS unsigned*)(lds + 131072 + 64));
    for (int ph = a.ph_lo; ph < a.ph_hi; ++ph) {
        int tid_ = threadIdx.x; asm volatile("" : "+v"(tid_)); const int tid = tid_, lane = tid & 63, wave = __builtin_amdgcn_readfirstlane(tid >> 6);
        const int gw = blockIdx.x * NWAVES + wave;
        if (ph == 0) { if (PHON(10)) { for (int rep = 0; rep < REP_PREP; ++rep) {
            for (int it = blockIdx.x; it < 2 * 384; it += G) mod_item(a.in[I_C], a.in[I_WADA], a.in[I_BADA], mod, (LAS float*)lds, it, tid);
            LAS float* scr = (LAS float*)(lds + wave * 16384);
            constexpr int I_IN8 = 32 * (QKVW / 32), I_I16 = 32 * (IDXW / 32), I_G8 = 32 * 128, I_PA = 8 * 64, I_PB = 16 * 64, I_O = 32 * 64, I_UP = 32 * 256, I_DN = 128 * 64;
            constexpr int PER_LAYER = I_IN8 + I_I16 + I_G8 + I_PA + I_PB + I_O + I_UP + I_DN;
            for (int it = gw; it < 2 * PER_LAYER; it += NGW) {
                const int l = it / PER_LAYER; int r = it % PER_LAYER; unsigned char* wl = ws + WS_W + (size_t)l * W_LAYER;
                const float* win = a.in[I_WIN] + (size_t)l * DM * NIN;
                if (r < I_IN8) { transpose_item<true>(win, NIN, DM, QKVW, QKVW, wl + W_IN8, scr, r, lane); continue; } r -= I_IN8;
                if (r < I_I16) { transpose_item<false>(win + QKVW, NIN, DM, NIN - QKVW, IDXW, wl + W_I16, scr, r, lane); continue; } r -= I_I16;
                if (r < I_G8) { transpose_item<true>(a.in[I_WG] + (size_t)l * DM * 4096, 4096, DM, 4096, 4096, wl + W_G8, scr, r, lane); continue; } r -= I_G8;
                if (r < I_PA) { transpose_item<false>(a.in[I_WPA] + (size_t)l * 512 * DM, DM, 512, DM, DM, wl + W_PA, scr, r, lane); continue; } r -= I_PA;
                if (r < I_PB) { transpose_item<false>(a.in[I_WPB] + (size_t)l * 1024 * DM, DM, 1024, DM, DM, wl + W_PB, scr, r, lane); continue; } r -= I_PB;
                if (r < I_O) { transpose_item<false>(a.in[I_WO] + (size_t)l * DM * DM, DM, DM, DM, DM, wl + W_O, scr, r, lane); continue; } r -= I_O;
                if (r < I_UP) { transpose_item<false>(a.in[I_WUP] + (size_t)l * DM * HIDN, HIDN, DM, HIDN, HIDN, wl + W_UP, scr, r, lane); continue; } r -= I_UP;
                transpose_item<false>(a.in[I_WDN] + (size_t)l * HIDN * DM, DM, HIDN, DM, DM, wl + W_DN, scr, r, lane);
            }
            __syncthreads(); } }
        } else {
            const int q = ph - 1, bl = q / 10, k = q % 10, b = bl >> 1, l = bl & 1;
            const unsigned char* wl = ws + WS_W + (size_t)l * W_LAYER;
            const float* md = mod + ((size_t)l * 2 + b) * NMOD;
            float* outb = a.out + (size_t)b * SEQ * DM;
            const float* xin = (l == 0) ? a.in[I_X] + (size_t)b * SEQ * DM : outb;
            if (k == 0) { if (PHON(0)) {
                for (int rep = 0; rep < REP_N; ++rep) for (int t = gw; t < SEQ; t += NGW) norm_row<true>(xin + (size_t)t * DM, md, md + DM, H + (size_t)t * DM, H8 + (size_t)t * DM, lane);
                for (int i = gw * 64 + lane; i < SEQ; i += NGW * 64) RS[i] = 0.f;
                { const bf16_t* WupT = (const bf16_t*)(wl + W_UP); const float* sh2 = md + 3 * DM;
                  for (int n = gw; n < HIDN; n += NGW) { const u32x4* wrow = (const u32x4*)(WupT + (size_t)n * DM); float s = 0.f;
#pragma unroll
                      for (int j = 0; j < 4; ++j) { const u32x4 w = wrow[lane + 64 * j]; const f32x4 h0 = *(const f32x4*)(sh2 + 8 * (lane + 64 * j)), h1 = *(const f32x4*)(sh2 + 8 * (lane + 64 * j) + 4);
                          s += (bf2f(w.x & 0xffffu) * h0[0] + __builtin_bit_cast(float, w.x & 0xffff0000u) * h0[1]) + (bf2f(w.y & 0xffffu) * h0[2] + __builtin_bit_cast(float, w.y & 0xffff0000u) * h0[3])
                             + (bf2f(w.z & 0xffffu) * h1[0] + __builtin_bit_cast(float, w.z & 0xffff0000u) * h1[1]) + (bf2f(w.w & 0xffffu) * h1[2] + __builtin_bit_cast(float, w.w & 0xffff0000u) * h1[3]); }
                      s = wave_sum(s); if (lane == 0) BVEC[n] = s; } }
            } } else if (k == 1) { if (PHON(1)) {
                for (int rep = 0; rep < REP_G; ++rep) {
                { Epi<0> E{QKV, nullptr, (const bf16_t*)V8, nullptr, nullptr, 1.f / W8_SCALE}; run_gemm<0, true>(lds, H8, wl + W_IN8, QKVW, DM / 2, E); }
                { Epi<6> E{nullptr, IDXF, nullptr, nullptr, nullptr, 1.f}; run_gemm<6>(lds, H, wl + W_I16, IDXW, DM, E, (int)gridDim.x / 2); }
                { Epi<1> E{GT, nullptr, nullptr, a.in[I_BG] + (size_t)l * 4096, nullptr, 1.f / W8_SCALE}; run_gemm<1, true>(lds, H8, wl + W_G8, 4096, DM / 2, E); }
                }
            } } else if (k == 2) { if (PHON(2)) {
                const int* pos = (const int*)a.in[I_POS] + (size_t)b * SEQ;
                for (int rep = 0; rep < REP_POST; ++rep) for (int t = gw; t < SEQ; t += NGW)
                    post_token(pos[t], a.in[I_GAQ] + l * 128, a.in[I_GAK] + l * 128, a.in[I_GBQ] + l * 128, a.in[I_GBK] + l * 128, a.in[I_GIK] + l * 64,
                               QKV + (size_t)t * QKVW, IDXF + (size_t)t * IDXW, IQ + (size_t)t * 1024, IK + (size_t)t * 64, IW + (size_t)t * 16, K8 + (size_t)t * 1024, V8 + (size_t)t * 1024, lane);
            } } else if (k == 3) { if (PHON(3)) {
                for (int rep = 0; rep < REP_DIL; ++rep) for (int u = blockIdx.x; u < 1536; u += G) dilated_block(QKV, OG, LSE, lds, u, tid);
                __syncthreads();
                for (int rep = 0; rep < REP_IDX; ++rep) for (int pr = gw; pr < SEQ / NQI / 2; pr += NGW) {
                    indexer_unit(IQ, IK, IW, SEL, lds + wave * 16384, (SEQ / NQI - 1 - pr) * NQI, lane); indexer_unit(IQ, IK, IW, SEL, lds + wave * 16384, pr * NQI, lane); }
                __syncthreads();
            } } else if (k == 4) { if (PHON(4)) {
                const int h = blockIdx.x & 7, qg = (blockIdx.x >> 3) * NWAVES + wave, nqg = ((G + 7) >> 3) * NWAVES;
                for (int u = gw; u < SEQ * 4; u += NGW) dilated_merge(OG, LSE, OA, u >> 2, u & 3, lane);
                for (int rep = 0; rep < REP_SP; ++rep)
                if ((G & 7) == 0) { int seln[4];
#pragma unroll
                    for (int s = 0; s < 4; ++s) seln[s] = (int)SEL[(size_t)min(qg, SEQ - 1) * 256 + 64 * s + lane];
                    for (int t = qg; t < SEQ; t += nqg) { int selc[4];
#pragma unroll
                        for (int s = 0; s < 4; ++s) selc[s] = seln[s];
                        const int tn = min(t + nqg, SEQ - 1);
#pragma unroll
                        for (int s = 0; s < 4; ++s) seln[s] = (int)SEL[(size_t)tn * 256 + 64 * s + lane];
                        sparse_unit7(QKV, K8, V8, selc, OB, lds + wave * 4096, t, h, lane); } }
                else { for (int u = gw; u < SEQ * 8; u += NGW) { const int t = u >> 3; int selc[4];
#pragma unroll
                        for (int s = 0; s < 4; ++s) selc[s] = (int)SEL[(size_t)t * 256 + 64 * s + lane];
                        sparse_unit7(QKV, K8, V8, selc, OB, lds + wave * 4096, t, u & 7, lane); } }
            } } else if (k == 5) { if (PHON(5)) {
                for (int rep = 0; rep < REP_P; ++rep) {
                { Epi<2> E{MRG, nullptr, GT, nullptr, nullptr, 1.f}; run_gemm<2>(lds, OA, wl + W_PA, DM, 512, E); }
                { Epi<3> E{MRG, nullptr, GT, nullptr, nullptr, 1.f}; run_gemm<3>(lds, OB, wl + W_PB, DM, 1024, E); }
                }
            } } else if (k == 6) { if (PHON(6)) {
                Epi<7> E{H, outb, nullptr, md + 2 * DM, xin, 1.f, md + 4 * DM, RS}; run_gemm<7>(lds, MRG, wl + W_O, DM, DM, E);
            } } else if (k == 7) { if (PHON(7)) {
            } } else if (k == 8) { if (PHON(8)) {
                for (int rep = 0; rep < REP_G; ++rep) {                 Epi<8> E{HID, nullptr, nullptr, BVEC, nullptr, 1.f, nullptr, RS}; run_gemm<8>(lds, H, wl + W_UP, HIDN, DM, E); }
            } } else { if (PHON(9)) {
                Epi<4> E{nullptr, outb, nullptr, md + 5 * DM, outb, 1.f}; run_gemm<4>(lds, HID, wl + W_DN, DM, HIDN, E);
            } }
        }
        if (ph + 1 < a.ph_hi && !(ph > 0 && (ph - 1) % 10 == 7)) { if (ph == a.ph_lo) grid.sync(); else xcd_barrier(xb); }
    }
}

#ifndef MK_MULTI
#define MK_MULTI 0
#endif
extern "C" void kernel_launch(void* const* d_in, const int* in_sizes, int n_in, void* d_out, int out_size, void* d_ws, size_t ws_size, hipStream_t stream) {
    static int grid = 0;
    if (grid == 0) {
        if (n_in != 18 || out_size != NB * SEQ * DM || ws_size < WS_END) { fprintf(stderr, "kernel_launch: unexpected shapes (n_in %d out %d ws %zu)\n", n_in, out_size, ws_size); grid = -1; return; }
        int dev = 0, cus = 0, per_cu = 0;
        (void)hipGetDevice(&dev); (void)hipDeviceGetAttribute(&cus, hipDeviceAttributeMultiprocessorCount, dev);
        (void)hipFuncSetAttribute((const void*)mega, hipFuncAttributeMaxDynamicSharedMemorySize, LDS_BYTES);
        if (hipOccupancyMaxActiveBlocksPerMultiprocessor(&per_cu, (const void*)mega, NTHREADS, LDS_BYTES) != hipSuccess || per_cu < 1) per_cu = 1;
        (void)hipGetLastError();
        grid = cus * per_cu;
    }
    if (grid < 0) return;
    Args a{};
    for (int i = 0; i < 18; ++i) a.in[i] = (const float*)d_in[i];
    a.out = (float*)d_out; a.ws = (unsigned char*)d_ws;
#if MK_MULTI
    for (int ph = 0; ph < N_PHASES; ++ph) { a.ph_lo = ph; a.ph_hi = ph + 1; hipLaunchKernelGGL(mega, dim3(grid), dim3(NTHREADS), LDS_BYTES, stream, a); }
#else
    (void)hipMemsetAsync((unsigned char*)d_ws + WS_BAR, 0, BAR_BYTES, stream);
    a.ph_lo = 0; a.ph_hi = N_PHASES; void* args[] = {&a};
    hipError_t e = hipLaunchCooperativeKernel((const void*)mega, dim3(grid), dim3(NTHREADS), args, LDS_BYTES, stream);
    if (e != hipSuccess) fprintf(stderr, "cooperative launch failed: %s (grid %d)\n", hipGetErrorString(e), grid);
#endif
}
```
